# Optimizing an MI355X kernel written in HIP

```python
import jax, jax.numpy as jnp
from jax import lax
import numpy as np

D_MODEL = 1024
BATCH = 32
SEQ = 2048
DEPTH = 2

D_CONV = D_MODEL
CONV_GROUPS = 16
CONV_WIDTH = 3
D_SGU = D_MODEL
SGU_GROUPS = 8
SGU_GROUP_DIM = D_SGU // SGU_GROUPS
CHUNK = 128
D_FF = 2816
N_BRANCH = 2
EPS = 1e-6

IN_COLS = 3 * D_CONV + 2 * D_SGU + N_BRANCH * D_MODEL

kernel_name = "hybrid_shortconv_sgu_gated_merge"


def rmsnorm(x, g):
    xf = x.astype(jnp.float32)
    y = xf * lax.rsqrt(jnp.mean(xf * xf, axis=-1, keepdims=True) + EPS)
    return (y * g.astype(jnp.float32)).astype(x.dtype)


def layernorm(x, g, b):
    xf = x.astype(jnp.float32)
    mu = jnp.mean(xf, axis=-1, keepdims=True)
    xc = xf - mu
    var = jnp.mean(xc * xc, axis=-1, keepdims=True)
    y = xc * lax.rsqrt(var + EPS)
    return (y * g.astype(jnp.float32) + b.astype(jnp.float32)).astype(x.dtype)


def causal_dwconv3(x, w):
    s = x.shape[1]
    xp = jnp.pad(x, ((0, 0), (CONV_WIDTH - 1, 0), (0, 0)))
    return xp[:, :s] * w[0] + xp[:, 1:s + 1] * w[1] + xp[:, 2:s + 2] * w[2]


def short_conv_mixer(b_gate, c_gate, xin, conv_w):
    return b_gate * causal_dwconv3(c_gate * xin, conv_w)


def spatial_gating_mixer(u, v, ln_g, ln_b, w_s, b_s):
    bsz, s, _ = v.shape
    n_chunks = s // CHUNK
    vn = layernorm(v, ln_g, ln_b).reshape(bsz, n_chunks, CHUNK, SGU_GROUPS, SGU_GROUP_DIM)
    mask = jnp.tril(jnp.ones((CHUNK, CHUNK), dtype=bool))
    w = jnp.where(mask[None], w_s, jnp.zeros((), w_s.dtype))
    mixed = jnp.einsum('gts,bnsgc->bntgc', w, vn)
    mixed = mixed + jnp.swapaxes(b_s, 0, 1)[None, None, :, :, None]
    return u * mixed.reshape(bsz, s, D_SGU)


def conv_gated_mlp(h, w_up, conv_w, w_down):
    up = causal_dwconv3(h @ w_up, conv_w)
    gate, val = jnp.split(up, 2, axis=-1)
    return (jax.nn.silu(gate) * val) @ w_down


def setup_inputs(seed: int = 0) -> dict:
    key = jax.random.key(seed)
    ks = jax.random.split(key, 16)
    f32 = jnp.float32

    def nrm(k, shape, scale):
        return jax.random.normal(k, shape, f32) * scale

    x = jax.random.normal(ks[0], (BATCH, SEQ, D_MODEL), f32)
    mix_norm_g = 1.0 + nrm(ks[1], (DEPTH, D_MODEL), 0.02)
    w_in = nrm(ks[2], (DEPTH, D_MODEL, IN_COLS), D_MODEL ** -0.5)
    conv_a_w = nrm(ks[3], (DEPTH, CONV_WIDTH, D_CONV), CONV_WIDTH ** -0.5)
    ln_v_g = 1.0 + nrm(ks[4], (DEPTH, D_SGU), 0.02)
    ln_v_b = nrm(ks[5], (DEPTH, D_SGU), 0.02)
    w_s = nrm(ks[6], (DEPTH, SGU_GROUPS, CHUNK, CHUNK), CHUNK ** -0.5)
    b_s = 1.0 + nrm(ks[7], (DEPTH, SGU_GROUPS, CHUNK), 0.02)
    w_out = nrm(ks[8], (DEPTH, D_MODEL, D_MODEL), D_MODEL ** -0.5)
    ffn_norm_g = 1.0 + nrm(ks[9], (DEPTH, D_MODEL), 0.02)
    w_up = nrm(ks[10], (DEPTH, D_MODEL, 2 * D_FF), D_MODEL ** -0.5)
    conv_ffn_w = nrm(ks[11], (DEPTH, CONV_WIDTH, 2 * D_FF), CONV_WIDTH ** -0.5)
    w_down = nrm(ks[12], (DEPTH, D_FF, D_MODEL), D_FF ** -0.5)
    final_norm_g = 1.0 + nrm(ks[13], (D_MODEL,), 0.02)
    return {"x": x, "mix_norm_g": mix_norm_g, "w_in": w_in, "conv_a_w": conv_a_w,
            "ln_v_g": ln_v_g, "ln_v_b": ln_v_b, "w_s": w_s, "b_s": b_s,
            "w_out": w_out, "ffn_norm_g": ffn_norm_g, "w_up": w_up,
            "conv_ffn_w": conv_ffn_w, "w_down": w_down, "final_norm_g": final_norm_g}


def reference(x, mix_norm_g, w_in, conv_a_w, ln_v_g, ln_v_b, w_s, b_s, w_out,
              ffn_norm_g, w_up, conv_ffn_w, w_down, final_norm_g):
    split_pts = [D_CONV, 2 * D_CONV, 3 * D_CONV, 3 * D_CONV + D_SGU,
                 3 * D_CONV + 2 * D_SGU, 3 * D_CONV + 2 * D_SGU + D_MODEL]
    for l in range(DEPTH):
        h = rmsnorm(x, mix_norm_g[l])
        proj = h @ w_in[l]
        b_gate, c_gate, xin, u, v, g_a, g_b = jnp.split(proj, split_pts, axis=-1)
        y_a = short_conv_mixer(b_gate, c_gate, xin, conv_a_w[l])
        y_b = spatial_gating_mixer(u, v, ln_v_g[l], ln_v_b[l], w_s[l], b_s[l])
        merged = jax.nn.sigmoid(g_a) * y_a + jax.nn.sigmoid(g_b) * y_b
        x = x + merged @ w_out[l]
        h = rmsnorm(x, ffn_norm_g[l])
        x = x + conv_gated_mlp(h, w_up[l], conv_ffn_w[l], w_down[l])
    return rmsnorm(x, final_norm_g)
```

```cpp
#include <hip/hip_runtime.h>
#include <hip/hip_cooperative_groups.h>
#include <cstdio>
namespace cg = cooperative_groups;
namespace pg8 {
#define PG8_LAS __attribute__((address_space(3)))
typedef unsigned short bf16_t;
typedef short bf16x8 __attribute__((ext_vector_type(8)));
typedef float f32x4 __attribute__((ext_vector_type(4)));
typedef unsigned u32x4 __attribute__((ext_vector_type(4)));
constexpr int BM = 256, BK = 64, HALF = 128, HTB = HALF * BK * 2  , STAGE_BYTES = 8 * HTB, NXCD = 8, WGM = 8;

__host__ __device__ __forceinline__ int lds_byte(int r, int c) { const int st = (r >> 4) * 2 + (c >> 5), rr = r & 15, cc = c & 31, ob = rr * 64 + cc * 2; return st * 1024 + (ob ^ (((ob >> 9) & 1) << 5)); }
__host__ __device__ __forceinline__ void stage_rc(int b, int& R, int& C) { const int st = b / 1024, sb = b % 1024, swz = sb ^ (((sb >> 9) & 1) << 5); R = (st >> 1) * 16 + swz / 64; C = (st & 1) * 32 + (swz % 64) / 2; }
__host__ __device__ __forceinline__ int perm32(int rho) { const int n = rho >> 4, i = rho & 15; return 8 * (i >> 2) + 4 * n + (i & 3); }

struct Unit { int pm, pn; };
struct Gemm { const bf16_t* A; const bf16_t* Bt; int M, N, K; };

struct StaticOrder {
    int nM, nN, nwg, G, c;
    __host__ __device__ void init(int M, int N, int G_, int c_) { nM = M / BM; nN = N / BM; nwg = nM * nN; G = G_; c = c_; }
    __host__ __device__ bool next(int i, Unit& u) const {
        const long L = (long)i * G + c; if (L >= nwg) return false;
        int wgid = (int)L; { const int q = nwg / NXCD, r = nwg % NXCD, xcd = wgid % NXCD, off = wgid / NXCD; wgid = (xcd < r ? xcd * (q + 1) : r * (q + 1) + (xcd - r) * q) + off; }
        const int nig = WGM * nN, gid = wgid / nig, fm = gid * WGM, gsz = (nM - fm) < WGM ? (nM - fm) : WGM;
        u.pm = fm + ((wgid % nig) % gsz); u.pn = (wgid % nig) / gsz; return true;
    }
    __device__ __forceinline__ void a_ready(const Unit&) const {}
    __device__ __forceinline__ void done(const Unit&) const {}
};
__device__ __forceinline__ unsigned cvt_pk_bf16(float lo, float hi) { unsigned r; asm volatile("v_cvt_pk_bf16_f32 %0, %1, %2" : "=v"(r) : "v"(lo), "v"(hi)); return r; }
constexpr int MTOK = 32 * 2048, DM = 1024, SEQ = 2048, NIN = 7168, DFF = 2816, NUP = 2 * DFF, DEPTH = 2;
constexpr float EPS = 1e-6f;
typedef unsigned u32x4 __attribute__((ext_vector_type(4)));
typedef float f32x2 __attribute__((ext_vector_type(2)));

__device__ __forceinline__ float bf_lo(unsigned w) { return __uint_as_float(w << 16); }
__device__ __forceinline__ float bf_hi(unsigned w) { return __uint_as_float(w & 0xffff0000u); }
__device__ __forceinline__ float sigmoid_f(float x) { return __builtin_amdgcn_rcpf(1.0f + __builtin_amdgcn_exp2f(-1.44269504f * x)); }
__device__ __forceinline__ float dpp_ror1(float v) { return __builtin_bit_cast(float, __builtin_amdgcn_update_dpp(0, __builtin_bit_cast(int, v), 0x121, 0xf, 0xf, true)); }
__device__ __forceinline__ float dpp_ror2(float v) { return __builtin_bit_cast(float, __builtin_amdgcn_update_dpp(0, __builtin_bit_cast(int, v), 0x122, 0xf, 0xf, true)); }

__device__ __forceinline__ float row_rstd(const float* xss, int row, int fq) {
    const f32x4 p = *(const f32x4*)((const char*)xss + (unsigned)(row * 64 + fq * 16));
    float s = (p[0] + p[1]) + (p[2] + p[3]);
    s += __shfl_xor(s, 16); s += __shfl_xor(s, 32);
    return rsqrtf(s * (1.0f / DM) + EPS);
}

struct EpiIn {
    static constexpr bool PERM = true, AFTER_DRAIN = false;
    const float* xss; bf16_t *CX  , *V; float* vst; size_t ostride;
    __device__ __forceinline__ void operator()(f32x4 (&acc)[2][2][4][2], const Unit& u, int wr, int wc, int fr_, int fq_) const {
        int fr = fr_, fq = fq_; asm volatile("" : "+v"(fr), "+v"(fq));
        const int row0 = u.pm * BM + wr * 64 + fr;
        const int type = u.pn >> 3;
        if (type == 3) {
            const int vt = u.pn - 24, col0 = vt * 256 + wc * 32 + 8 * fq;
#pragma unroll
            for (int ai = 0; ai < 2; ++ai)
#pragma unroll
                for (int m = 0; m < 4; ++m) {
                    const int row = row0 + ai * 128 + m * 16; const float r = row_rstd(xss, row, fq); float s = 0.f, q = 0.f;
#pragma unroll
                    for (int bj = 0; bj < 2; ++bj) {
                        const f32x4 v0 = acc[ai][bj][m][0] * r, v1 = acc[ai][bj][m][1] * r;
                        u32x4 w; w.x = cvt_pk_bf16(v0[0], v0[1]); w.y = cvt_pk_bf16(v0[2], v0[3]); w.z = cvt_pk_bf16(v1[0], v1[1]); w.w = cvt_pk_bf16(v1[2], v1[3]);
                        *(u32x4*)((char*)V + (unsigned)((row * DM + col0 + bj * HALF) * 2)) = w;
#pragma unroll
                        for (int k = 0; k < 4; ++k) { const float a = bf_lo(w[k]), b = bf_hi(w[k]); s += a + b; q += a * a + b * b; }
                    }
                    s += __shfl_xor(s, 16); s += __shfl_xor(s, 32); q += __shfl_xor(q, 16); q += __shfl_xor(q, 32);
                    if (fq == 0) *(f32x2*)((char*)vst + (unsigned)((row * 16 + vt * 4 + wc) * 8)) = (f32x2){s, q};
                }
        } else {
            bf16_t* O = CX + (size_t)type * ostride;
            const int col0 = (u.pn & 7) * 128 + wc * 32 + 8 * fq;
#pragma unroll
            for (int ai = 0; ai < 2; ++ai)
#pragma unroll
                for (int m = 0; m < 4; ++m) {
                    const int row = row0 + ai * 128 + m * 16; const float r = row_rstd(xss, row, fq);
                    f32x4 o[2];
#pragma unroll
                    for (int n = 0; n < 2; ++n) {
                        const f32x4 a = acc[ai][0][m][n] * r, b = acc[ai][1][m][n] * r;
                        if (type == 0) o[n] = a * b;
                        else { o[n][0] = a[0] * sigmoid_f(b[0]); o[n][1] = a[1] * sigmoid_f(b[1]); o[n][2] = a[2] * sigmoid_f(b[2]); o[n][3] = a[3] * sigmoid_f(b[3]); }
                    }
                    u32x4 w; w.x = cvt_pk_bf16(o[0][0], o[0][1]); w.y = cvt_pk_bf16(o[0][2], o[0][3]); w.z = cvt_pk_bf16(o[1][0], o[1][1]); w.w = cvt_pk_bf16(o[1][2], o[1][3]);
                    *(u32x4*)((char*)O + (unsigned)((row * DM + col0) * 2)) = w;
                }
        }
    }
};

struct EpiRes {
    static constexpr bool PERM = true, AFTER_DRAIN = false;
    bf16_t* X; float* xss;
    __device__ __forceinline__ void operator()(f32x4 (&acc)[2][2][4][2], const Unit& u, int wr, int wc, int fr_, int fq_) const {
        int fr = fr_, fq = fq_; asm volatile("" : "+v"(fr), "+v"(fq));
        const int row0 = u.pm * BM + wr * 64 + fr, col0 = u.pn * BM + wc * 32 + 8 * fq;
#pragma unroll
        for (int ai = 0; ai < 2; ++ai)
#pragma unroll
            for (int m = 0; m < 4; ++m) {
                const int row = row0 + ai * 128 + m * 16; float q = 0.f;
#pragma unroll
                for (int bj = 0; bj < 2; ++bj) {
                    u32x4* p = (u32x4*)((char*)X + (unsigned)((row * DM + col0 + bj * HALF) * 2));
                    const u32x4 old = *p; const f32x4 a0 = acc[ai][bj][m][0], a1 = acc[ai][bj][m][1];
                    u32x4 w;
                    w.x = cvt_pk_bf16(bf_lo(old.x) + a0[0], bf_hi(old.x) + a0[1]); w.y = cvt_pk_bf16(bf_lo(old.y) + a0[2], bf_hi(old.y) + a0[3]);
                    w.z = cvt_pk_bf16(bf_lo(old.z) + a1[0], bf_hi(old.z) + a1[1]); w.w = cvt_pk_bf16(bf_lo(old.w) + a1[2], bf_hi(old.w) + a1[3]);
                    *p = w;
#pragma unroll
                    for (int k = 0; k < 4; ++k) { const float a = bf_lo(w[k]), b = bf_hi(w[k]); q += a * a + b * b; }
                }
                q += __shfl_xor(q, 16); q += __shfl_xor(q, 32);
                if (fq == 0) *(float*)((char*)xss + (unsigned)((row * 16 + u.pn * 4 + wc) * 4)) = q;
            }
    }
};

__device__ __forceinline__ f32x4 ror1_4(f32x4 v) { return (f32x4){dpp_ror1(v[0]), dpp_ror1(v[1]), dpp_ror1(v[2]), dpp_ror1(v[3])}; }
__device__ __forceinline__ f32x4 ror2_4(f32x4 v) { return (f32x4){dpp_ror2(v[0]), dpp_ror2(v[1]), dpp_ror2(v[2]), dpp_ror2(v[3])}; }
__device__ __forceinline__ f32x4 sel4(bool c, f32x4 a, f32x4 b) { return (f32x4){c ? a[0] : b[0], c ? a[1] : b[1], c ? a[2] : b[2], c ? a[3] : b[3]}; }
struct EpiUp {
    static constexpr bool PERM = true, AFTER_DRAIN = false;
    const float* xss; const float* cw  ; bf16_t* ACT; bf16_t* RAWB  ;
    __device__ __forceinline__ void operator()(f32x4 (&acc)[2][2][4][2], const Unit& u, int wr, int wc, int fr_, int fq_) const {
        int fr = fr_, fq = fq_; asm volatile("" : "+v"(fr), "+v"(fq));
        const int row0 = u.pm * BM + wr * 64 + fr;
        const int tc0 = wc * 32 + 8 * fq;
#pragma unroll
        for (int ai = 0; ai < 2; ++ai)
#pragma unroll
            for (int m = 0; m < 4; ++m) {
                const float r = row_rstd(xss, row0 + ai * 128 + m * 16, fq);
#pragma unroll
                for (int bj = 0; bj < 2; ++bj) { acc[ai][bj][m][0] *= r; acc[ai][bj][m][1] *= r; }
                if (m == 0 || m == 3) {
                    const bool sv = (m == 0) ? (fr < 2) : (fr >= 14);
                    if (sv) {
                        const int grp = (u.pm * BM + ai * 128 + wr * 64) >> 6, slot = (m == 0) ? fr : (fr - 12);
#pragma unroll
                        for (int bj = 0; bj < 2; ++bj) {
                            const f32x4 v0 = acc[ai][bj][m][0], v1 = acc[ai][bj][m][1];
                            u32x4 w; w.x = cvt_pk_bf16(v0[0], v0[1]); w.y = cvt_pk_bf16(v0[2], v0[3]); w.z = cvt_pk_bf16(v1[0], v1[1]); w.w = cvt_pk_bf16(v1[2], v1[3]);
                            *(u32x4*)((char*)RAWB + (unsigned)(((grp * 4 + slot) * NUP + u.pn * 256 + bj * HALF + tc0) * 2)) = w;
                        }
                    }
                }
            }
        const bool f1 = fr >= 1, f2 = fr >= 2;
        const f32x4 zero4 = (f32x4){0.f, 0.f, 0.f, 0.f};
#pragma unroll
        for (int n = 0; n < 2; ++n) {
            f32x4 w[2][3];
#pragma unroll
            for (int bj = 0; bj < 2; ++bj)
#pragma unroll
                for (int t = 0; t < 3; ++t) w[bj][t] = *(const f32x4*)((const char*)cw + (unsigned)((t * NUP + bj * DFF + u.pn * 128 + tc0 + 4 * n) * 4));
#pragma unroll
            for (int ai = 0; ai < 2; ++ai) {
                f32x4 y[2][4];
#pragma unroll
                for (int bj = 0; bj < 2; ++bj) {
                    f32x4 a1n = ror1_4(acc[ai][bj][3][n]), a2n = ror2_4(acc[ai][bj][3][n]);
#pragma unroll
                    for (int m = 3; m >= 0; --m) {
                        const f32x4 a1 = a1n, a2 = a2n;
                        if (m > 0) { a1n = ror1_4(acc[ai][bj][m - 1][n]); a2n = ror2_4(acc[ai][bj][m - 1][n]); } else { a1n = zero4; a2n = zero4; }
                        y[bj][m] = w[bj][2] * acc[ai][bj][m][n] + w[bj][1] * sel4(f1, a1, a1n) + w[bj][0] * sel4(f2, a2, a2n);
                    }
                }
#pragma unroll
                for (int m = 0; m < 4; ++m) {
                    const int row = row0 + ai * 128 + m * 16;
                    const f32x4 g = y[0][m], v = y[1][m];
                    const unsigned lo = cvt_pk_bf16(g[0] * sigmoid_f(g[0]) * v[0], g[1] * sigmoid_f(g[1]) * v[1]), hi = cvt_pk_bf16(g[2] * sigmoid_f(g[2]) * v[2], g[3] * sigmoid_f(g[3]) * v[3]);
                    *(unsigned long long*)((char*)ACT + (unsigned)((row * DFF + u.pn * 128 + tc0 + 4 * n) * 2)) = (unsigned long long)lo | ((unsigned long long)hi << 32);
                }
            }
        }
    }
};
template <class Epi, class Sched, bool STAMP = false>
__device__ __forceinline__ void gemm_phase(PG8_LAS unsigned char* lds, const Gemm g, const Sched& S, const Epi& E, unsigned long long* stamps) {
    int tid_ = threadIdx.x; asm volatile("" : "+v"(tid_));
    const int tid = tid_, wid = __builtin_amdgcn_readfirstlane(tid >> 6), lane = tid & 63, wr = wid >> 2, wc = wid & 3, fr = lane & 15, fq = lane >> 4;
    const int K = g.K, nt = K / BK;
    int ts_lo = 0, ts_hi = 0, nts = 0; const unsigned long long rt_entry = STAMP ? (unsigned long long)wall_clock64() : 0ull;
#define PG8_STAMP() do { if (STAMP && wid == 0 && nts < 64) { const unsigned long long _c = (unsigned long long)clock64(); \
        ts_lo = (lane == nts) ? (int)(unsigned)_c : ts_lo; ts_hi = (lane == nts) ? (int)(unsigned)(_c >> 32) : ts_hi; ++nts; } } while (0)
    PG8_STAMP();
    unsigned voffA[2], voffB[2];
#pragma unroll
    for (int i = 0; i < 2; ++i) { int R, C; stage_rc(tid * 16 + i * 8192, R, C); const int Rb = Epi::PERM ? ((R & ~31) + perm32(R & 31)) : R;
        voffA[i] = (unsigned)(R * K + C) * 2u; voffB[i] = (unsigned)(Rb * K + C) * 2u; }
    const size_t kstep = (size_t)(BK * 2);
    const size_t hstep = (size_t)HALF * K * 2;
    const size_t tstep = 2 * hstep;
    const unsigned ldsw = (unsigned)wid * 1024u;
    const int aoff = lds_byte(wr * 64 + fr, fq * 8), boff = lds_byte(wc * 32 + fr, fq * 8);
#define PG8_SA(b, h) (((b) * 2 + (h)) * HTB)
#define PG8_SB(b, h) ((4 + (b) * 2 + (h)) * HTB)
#define PG8_STAGE(bufoff, gbase, voff) do { _Pragma("unroll") for (int _i = 0; _i < 2; ++_i) \
        __builtin_amdgcn_global_load_lds((const unsigned*)((const char*)(gbase) + (voff)[_i]), (PG8_LAS unsigned*)(lds + (bufoff) + ldsw + _i * 8192), 16, 0, 0); } while (0)
#define PG8_LDA(dst, b, h) do { _Pragma("unroll") for (int m = 0; m < 4; ++m) _Pragma("unroll") for (int k = 0; k < 2; ++k) dst[m][k] = *(const PG8_LAS bf16x8*)(lds + PG8_SA(b, h) + aoff + m * 2048 + k * 1024); } while (0)
#define PG8_LDB(dst, b, h) do { _Pragma("unroll") for (int n = 0; n < 2; ++n) _Pragma("unroll") for (int k = 0; k < 2; ++k) dst[n][k] = *(const PG8_LAS bf16x8*)(lds + PG8_SB(b, h) + boff + n * 2048 + k * 1024); } while (0)
#define PG8_MMA(ai, bj, At, Bt) do { __builtin_amdgcn_s_setprio(1); _Pragma("unroll") for (int m = 0; m < 4; ++m) _Pragma("unroll") for (int n = 0; n < 2; ++n) _Pragma("unroll") for (int k = 0; k < 2; ++k) \
        acc[ai][bj][m][n] = __builtin_amdgcn_mfma_f32_16x16x32_bf16(Bt[n][k], At[m][k], acc[ai][bj][m][n], 0, 0, 0); __builtin_amdgcn_s_setprio(0); } while (0)
#define PG8_WAIT_V(n) asm volatile("s_waitcnt vmcnt(" #n ")" ::: "memory")
#define PG8_WAIT_L(n) asm volatile("s_waitcnt lgkmcnt(" #n ")" ::: "memory")
#define PG8_BAR __builtin_amdgcn_s_barrier()
#define PG8_SCHED __builtin_amdgcn_sched_barrier(0)
    Unit cur, nxt; int ui = 0;
    if (!S.next(0, cur)) return;
    f32x4 acc[2][2][4][2];
#pragma unroll
    for (int a = 0; a < 2; ++a)
#pragma unroll
        for (int b = 0; b < 2; ++b)
#pragma unroll
            for (int m = 0; m < 4; ++m)
#pragma unroll
                for (int n = 0; n < 2; ++n) acc[a][b][m][n] = (f32x4){0.f, 0.f, 0.f, 0.f};
    bf16x8 At[4][2], B0[2][2], B1[2][2];
    const char* cA = (const char*)g.A + (size_t)cur.pm * tstep; const char* cB = (const char*)g.Bt + (size_t)cur.pn * tstep;
    S.a_ready(cur);
    PG8_STAGE(PG8_SB(0, 0), cB, voffB); PG8_STAGE(PG8_SA(0, 0), cA, voffA); PG8_STAGE(PG8_SB(0, 1), cB + hstep, voffB); PG8_STAGE(PG8_SA(0, 1), cA + hstep, voffA);
    if (wr == 1) PG8_BAR;
    PG8_WAIT_V(4); PG8_BAR;
    PG8_STAGE(PG8_SB(1, 0), cB + kstep, voffB); PG8_STAGE(PG8_SA(1, 0), cA + kstep, voffA); PG8_STAGE(PG8_SB(1, 1), cB + hstep + kstep, voffB);
    PG8_WAIT_V(6); PG8_BAR;
    PG8_STAMP();
    for (;;) {
        const bool has_next = S.next(ui + 1, nxt);
        const char* nA = has_next ? (const char*)g.A + (size_t)nxt.pm * tstep : cA; const char* nB = has_next ? (const char*)g.Bt + (size_t)nxt.pn * tstep : cB;
        for (int t = 0; t < nt; t += 2) {
            const bool last = (t == nt - 2);
            const char* a1 = cA + (size_t)(t + 1) * kstep;
            const char* a2 = last ? nA : cA + (size_t)(t + 2) * kstep; const char* b2 = last ? nB : cB + (size_t)(t + 2) * kstep;
            const char* a3 = a2 + kstep; const char* b3 = b2 + kstep;
            if (last && has_next) S.a_ready(nxt);
            PG8_LDB(B0, 0, 0); PG8_SCHED; PG8_LDA(At, 0, 0); PG8_STAGE(PG8_SA(1, 1), a1 + hstep, voffA);
            PG8_WAIT_L(8); PG8_BAR; PG8_WAIT_L(0); PG8_MMA(0, 0, At, B0); PG8_BAR; PG8_SCHED;
            PG8_LDB(B1, 0, 1); PG8_STAGE(PG8_SB(0, 0), b2, voffB);
            PG8_BAR; PG8_WAIT_L(0); PG8_MMA(0, 1, At, B1); PG8_BAR;
            PG8_LDA(At, 0, 1); PG8_STAGE(PG8_SA(0, 0), a2, voffA);
            PG8_BAR; PG8_WAIT_L(0); PG8_MMA(1, 0, At, B0); PG8_BAR; PG8_SCHED;
            PG8_STAGE(PG8_SB(0, 1), b2 + hstep, voffB);
            PG8_WAIT_V(6); PG8_BAR; PG8_MMA(1, 1, At, B1); PG8_BAR;
            PG8_LDB(B0, 1, 0); PG8_SCHED; PG8_LDA(At, 1, 0); PG8_STAGE(PG8_SA(0, 1), a2 + hstep, voffA);
            PG8_WAIT_L(8); PG8_BAR; PG8_WAIT_L(0); PG8_MMA(0, 0, At, B0); PG8_BAR; PG8_SCHED;
            PG8_LDB(B1, 1, 1); PG8_STAGE(PG8_SB(1, 0), b3, voffB);
            PG8_BAR; PG8_WAIT_L(0); PG8_MMA(0, 1, At, B1); PG8_BAR;
            PG8_LDA(At, 1, 1); PG8_STAGE(PG8_SA(1, 0), a3, voffA);
            PG8_BAR; PG8_WAIT_L(0); PG8_MMA(1, 0, At, B0); PG8_BAR; PG8_SCHED;
            PG8_STAGE(PG8_SB(1, 1), b3 + hstep, voffB);
            PG8_WAIT_V(6); PG8_BAR; PG8_MMA(1, 1, At, B1); PG8_BAR;
        }
        PG8_STAMP();
        if constexpr (!Epi::AFTER_DRAIN) { E(acc, cur, wr, wc, fr, fq); S.done(cur); }
        PG8_STAMP();
        if (!has_next) break;
#pragma unroll
        for (int a = 0; a < 2; ++a)
#pragma unroll
            for (int b = 0; b < 2; ++b)
#pragma unroll
                for (int m = 0; m < 4; ++m)
#pragma unroll
                    for (int n = 0; n < 2; ++n) acc[a][b][m][n] = (f32x4){0.f, 0.f, 0.f, 0.f};
        cur = nxt; cA = nA; cB = nB; ++ui;
    }
    PG8_WAIT_V(0);
    if (wr == 0) PG8_BAR;
    PG8_BAR;
    if constexpr (Epi::AFTER_DRAIN) { E.fused(acc, cur, wr, wc, fr, fq, lds, wid, lane); S.done(cur); }
    PG8_STAMP();
    if (STAMP && wid == 0) { stamps[lane] = lane < nts ? (((unsigned long long)(unsigned)ts_hi << 32) | (unsigned)ts_lo) : 0ull;
        if (lane == 62) stamps[62] = rt_entry; if (lane == 63) stamps[63] = (unsigned long long)wall_clock64(); }
#undef PG8_STAMP
#undef PG8_SA
#undef PG8_SB
#undef PG8_STAGE
#undef PG8_LDA
#undef PG8_LDB
#undef PG8_MMA
#undef PG8_WAIT_V
#undef PG8_WAIT_L
#undef PG8_BAR
#undef PG8_SCHED
}
}
using pg8::bf16_t; using pg8::f32x4; using pg8::bf16x8; using pg8::u32x4; using pg8::f32x2;
using pg8::MTOK; using pg8::DM; using pg8::SEQ; using pg8::NIN; using pg8::DFF; using pg8::NUP; using pg8::DEPTH; using pg8::EPS;
#define LAS __attribute__((address_space(3)))

constexpr size_t MiB = 1u << 20;
constexpr size_t WS_WIN = 0;
constexpr size_t WS_WOUT = 28 * MiB;
constexpr size_t WS_WUP = 32 * MiB;
constexpr size_t WS_WDN = 54 * MiB;
constexpr size_t WS_XSS = 66 * MiB;
constexpr size_t WS_VST = 70 * MiB;
constexpr size_t WS_RAWB = 78 * MiB;
constexpr size_t WS_X = 128 * MiB;
constexpr size_t WS_CX = 256 * MiB, WS_BSG = 384 * MiB, WS_UG = 512 * MiB, WS_V = 640 * MiB;
constexpr size_t WS_ACT = 256 * MiB;
constexpr size_t WS_MRG = 768 * MiB;
constexpr size_t WS_END = 896 * MiB;
constexpr int LDS_BYTES = 131072 + 2048;

struct Params {
    const float *x, *mix_g, *w_in, *conv_a, *ln_g, *ln_b, *w_s, *b_s, *w_out, *ffn_g, *w_up, *conv_f, *w_dn, *fin_g;
    float* out; unsigned char* ws;
};

__device__ __forceinline__ unsigned f2bf(float f) { unsigned u = __float_as_uint(f); return (u + 0x7fffu + ((u >> 16) & 1u)) >> 16; }
__device__ __forceinline__ unsigned pk2(float lo, float hi) { return pg8::cvt_pk_bf16(lo, hi); }
__device__ __forceinline__ float wave_sum(float v) {
#pragma unroll
    for (int o = 1; o < 64; o <<= 1) v += __shfl_xor(v, o);
    return v;
}

__device__ __forceinline__ void p0_item(const float* W, int N, int K, const float* gk, bf16_t* WT, int k0, int srccol, int dstrow, LAS float* scr, int lane) {
#pragma unroll 8
    for (int i = 0; i < 32; ++i) { const int kk = 2 * i + (lane >> 5); float v = W[(size_t)(k0 + kk) * N + srccol + (lane & 31)]; if (gk) v *= gk[k0 + kk]; scr[kk * 33 + (lane & 31)] = v; }
    asm volatile("s_waitcnt lgkmcnt(0)" ::: "memory");
    const int c = lane & 7;
#pragma unroll
    for (int j = 0; j < 4; ++j) { const int n = (lane >> 3) + 8 * j; const LAS float* s = scr + (8 * c) * 33 + n;
        u32x4 o; o.x = pk2(s[0 * 33], s[1 * 33]); o.y = pk2(s[2 * 33], s[3 * 33]); o.z = pk2(s[4 * 33], s[5 * 33]); o.w = pk2(s[6 * 33], s[7 * 33]);
        *(u32x4*)(WT + (size_t)(dstrow + n) * K + k0 + 8 * c) = o; }
    asm volatile("s_waitcnt lgkmcnt(0)" ::: "memory");
}
__device__ __forceinline__ int in_srccol(int np) {
    const int pn = np >> 8, r = np & 255, type = pn >> 3, cb = pn & 7, h = r >> 7, i = r & 127;
    if (type == 0) return (h ? 2048 : 1024) + 128 * cb + i;
    if (type == 1) return (h ? 5120 : 0) + 128 * cb + i;
    if (type == 2) return (h ? 6144 : 3072) + 128 * cb + i;
    return 4096 + 256 * (pn - 24) + r;
}
__device__ __forceinline__ int up_srccol(int np) { const int pn = np >> 8, r = np & 255; return ((r >> 7) ? DFF : 0) + 128 * pn + (r & 127); }

__device__ __forceinline__ void p0_phase(const Params& P, LAS unsigned char* lds) {
    int tid_ = threadIdx.x; asm volatile("" : "+v"(tid_));
    const int tid = tid_, lane = tid & 63, wave = tid >> 6;
    LAS float* scr = (LAS float*)(lds + wave * 16384);
    const int gw = blockIdx.x * 8 + wave, NGW = gridDim.x * 8;
    constexpr int I_IN = 16 * (NIN / 32), I_OUT = 16 * (DM / 32), I_UP = 16 * (NUP / 32), I_DN = (DFF / 64) * (DM / 32);
    constexpr int PER_L = I_IN + I_OUT + I_UP + I_DN;
    bf16_t* WIN = (bf16_t*)(P.ws + WS_WIN); bf16_t* WOUT = (bf16_t*)(P.ws + WS_WOUT); bf16_t* WUP = (bf16_t*)(P.ws + WS_WUP); bf16_t* WDN = (bf16_t*)(P.ws + WS_WDN);
    for (int it = gw; it < DEPTH * PER_L; it += NGW) {
        const int l = it / PER_L; int r = it % PER_L;
        if (r < I_IN) { const int kb = r / (NIN / 32), nb = r % (NIN / 32); p0_item(P.w_in + (size_t)l * DM * NIN, NIN, DM, P.mix_g + l * DM, WIN + (size_t)l * NIN * DM, 64 * kb, in_srccol(32 * nb), 32 * nb, scr, lane); continue; } r -= I_IN;
        if (r < I_OUT) { const int kb = r / (DM / 32), nb = r % (DM / 32); p0_item(P.w_out + (size_t)l * DM * DM, DM, DM, nullptr, WOUT + (size_t)l * DM * DM, 64 * kb, 32 * nb, 32 * nb, scr, lane); continue; } r -= I_OUT;
        if (r < I_UP) { const int kb = r / (NUP / 32), nb = r % (NUP / 32); p0_item(P.w_up + (size_t)l * DM * NUP, NUP, DM, P.ffn_g + l * DM, WUP + (size_t)l * NUP * DM, 64 * kb, up_srccol(32 * nb), 32 * nb, scr, lane); continue; } r -= I_UP;
        { const int kb = r / (DM / 32), nb = r % (DM / 32); p0_item(P.w_dn + (size_t)l * DFF * DM, DM, DFF, nullptr, WDN + (size_t)l * DM * DFF, 64 * kb, 32 * nb, 32 * nb, scr, lane); }
    }
    bf16_t* X = (bf16_t*)(P.ws + WS_X); float* xss = (float*)(P.ws + WS_XSS);
    for (int m = gw; m < MTOK; m += NGW) {
        const f32x4* xr = (const f32x4*)(P.x + (size_t)m * DM) + lane; float s = 0.f;
        unsigned long long* o8 = (unsigned long long*)(X + (size_t)m * DM) + lane;
#pragma unroll
        for (int j = 0; j < 4; ++j) { const f32x4 v = xr[64 * j]; const unsigned a = pk2(v[0], v[1]), b = pk2(v[2], v[3]);
            o8[64 * j] = (unsigned long long)a | ((unsigned long long)b << 32);
            const float f0 = pg8::bf_lo(a), f1 = pg8::bf_hi(a), f2 = pg8::bf_lo(b), f3 = pg8::bf_hi(b); s += (f0 * f0 + f1 * f1) + (f2 * f2 + f3 * f3); }
        s = wave_sum(s);
        if (lane < 16) xss[(size_t)m * 16 + lane] = lane == 0 ? s : 0.f;
    }
}

__device__ __forceinline__ int vt_key(int rho) { return ((rho >> 2) & 3) | (((rho >> 5) & 3) << 2); }
__device__ __forceinline__ void sgu_phase(const Params& P, LAS unsigned char* lds, int l) {
    int tid_ = threadIdx.x; asm volatile("" : "+v"(tid_));
    const int tid = tid_, lane = tid & 63, w = __builtin_amdgcn_readfirstlane(tid >> 6), fr = lane & 15, fq = lane >> 4;
    const int g = blockIdx.x & 7;
    LAS unsigned* WS = (LAS unsigned*)lds;
    LAS unsigned* VT = (LAS unsigned*)(lds + 32768);
    LAS f32x2* ST = (LAS f32x2*)(lds + 65536);
    LAS float* CW = (LAS float*)(lds + 65536 + 1024);
    const bf16_t* V = (const bf16_t*)(P.ws + WS_V); const bf16_t* UG = (const bf16_t*)(P.ws + WS_UG); const bf16_t* BSG = (const bf16_t*)(P.ws + WS_BSG); const bf16_t* CX = (const bf16_t*)(P.ws + WS_CX);
    bf16_t* MRG = (bf16_t*)(P.ws + WS_MRG); const float* vst = (const float*)(P.ws + WS_VST);
    __syncthreads();
    {
        const float* Wg = P.w_s + ((size_t)l * 8 + g) * 128 * 128;
#pragma unroll
        for (int i = 0; i < 4; ++i) { const int idx = tid + 512 * i, t = idx >> 4, s8 = idx & 15;
            const f32x4 a = *(const f32x4*)(Wg + t * 128 + 8 * s8), b = *(const f32x4*)(Wg + t * 128 + 8 * s8 + 4);
            float v[8] = {a[0], a[1], a[2], a[3], b[0], b[1], b[2], b[3]};
#pragma unroll
            for (int j = 0; j < 8; ++j) if (8 * s8 + j > t) v[j] = 0.f;
            u32x4 o; o.x = pk2(v[0], v[1]); o.y = pk2(v[2], v[3]); o.z = pk2(v[4], v[5]); o.w = pk2(v[6], v[7]);
            *(LAS u32x4*)(WS + t * 64 + ((4 * s8) ^ ((t & 15) << 2))) = o; }
        if (tid < 384) CW[tid] = P.conv_a[(size_t)l * 3 * DM + (tid >> 7) * DM + 128 * g + (tid & 127)];
    }
    const int c8 = tid & 15;
    float lg[8], lb[8];
#pragma unroll
    for (int j = 0; j < 8; ++j) { lg[j] = P.ln_g[l * DM + 128 * g + 8 * c8 + j]; lb[j] = P.ln_b[l * DM + 128 * g + 8 * c8 + j]; }
    const float bias = P.b_s[((size_t)l * 8 + g) * 128 + 16 * w + fr];
    for (int ck = blockIdx.x >> 3; ck < MTOK / 128; ck += gridDim.x >> 3) {
        const int row0 = ck * 128;
        __syncthreads();
        if (tid < 128) {
            const f32x4* p = (const f32x4*)(vst + (size_t)(row0 + tid) * 32); float s = 0.f, q = 0.f;
#pragma unroll
            for (int j = 0; j < 8; ++j) { const f32x4 v = p[j]; s += v[0] + v[2]; q += v[1] + v[3]; }
            const float mu = s * (1.0f / DM), var = q * (1.0f / DM) - mu * mu;
            ST[tid] = (f32x2){mu, rsqrtf(fmaxf(var, 0.f) + EPS)};
        }
        __syncthreads();
#pragma unroll
        for (int it = 0; it < 2; ++it) {
            const int sp = (tid >> 4) + 32 * it;
            const u32x4 v0 = *(const u32x4*)(V + (size_t)(row0 + 2 * sp) * DM + 128 * g + 8 * c8), v1 = *(const u32x4*)(V + (size_t)(row0 + 2 * sp + 1) * DM + 128 * g + 8 * c8);
            const f32x2 s0 = ST[2 * sp], s1 = ST[2 * sp + 1];
#pragma unroll
            for (int j = 0; j < 8; ++j) {
                const unsigned w0 = v0[j >> 1], w1 = v1[j >> 1];
                const float a = (j & 1) ? pg8::bf_hi(w0) : pg8::bf_lo(w0), b = (j & 1) ? pg8::bf_hi(w1) : pg8::bf_lo(w1);
                const float na = (a - s0[0]) * s0[1] * lg[j] + lb[j], nb = (b - s1[0]) * s1[1] * lg[j] + lb[j];
                const int rho = 32 * (c8 >> 2) + 16 * (j >> 2) + 4 * (c8 & 3) + (j & 3);
                VT[rho * 64 + (sp ^ (vt_key(rho) << 2))] = pk2(na, nb);
            }
        }
        __syncthreads();
        f32x4 acc[8];
#pragma unroll
        for (int nb = 0; nb < 8; ++nb) acc[nb] = (f32x4){0.f, 0.f, 0.f, 0.f};
        for (int kk = 0; kk <= (w >> 1); ++kk) {
            const bf16x8 wf = *(const LAS bf16x8*)(WS + (16 * w + fr) * 64 + ((16 * kk + 4 * fq) ^ (fr << 2)));
#pragma unroll
            for (int nb = 0; nb < 8; ++nb) { const int rho = 16 * nb + fr;
                const bf16x8 vf = *(const LAS bf16x8*)(VT + rho * 64 + ((16 * kk + 4 * fq) ^ (vt_key(rho) << 2)));
                acc[nb] = __builtin_amdgcn_mfma_f32_16x16x32_bf16(vf, wf, acc[nb], 0, 0, 0); }
        }
        const int t = 16 * w + fr; const size_t row = (size_t)row0 + t;
        const bool seq0 = (row0 % SEQ) == 0;
#pragma unroll
        for (int q = 0; q < 4; ++q) {
            const int ch = 32 * q + 8 * fq; const size_t off = row * DM + 128 * g + ch;
            const u32x4 ug = *(const u32x4*)(UG + off), bs = *(const u32x4*)(BSG + off), c0 = *(const u32x4*)(CX + off);
            u32x4 c1 = (u32x4){0u, 0u, 0u, 0u}, c2 = (u32x4){0u, 0u, 0u, 0u};
            if (!(seq0 && t < 1)) c1 = *(const u32x4*)(CX + off - DM);
            if (!(seq0 && t < 2)) c2 = *(const u32x4*)(CX + off - 2 * DM);
            u32x4 o;
#pragma unroll
            for (int k = 0; k < 4; ++k) {
                const int j0 = 2 * k, j1 = 2 * k + 1;
                const float m0 = acc[2 * q + (j0 >> 2)][j0 & 3] + bias, m1 = acc[2 * q + (j1 >> 2)][j1 & 3] + bias;
                const float ya0 = CW[256 + ch + j0] * pg8::bf_lo(c0[k]) + CW[128 + ch + j0] * pg8::bf_lo(c1[k]) + CW[ch + j0] * pg8::bf_lo(c2[k]);
                const float ya1 = CW[256 + ch + j1] * pg8::bf_hi(c0[k]) + CW[128 + ch + j1] * pg8::bf_hi(c1[k]) + CW[ch + j1] * pg8::bf_hi(c2[k]);
                o[k] = pk2(pg8::bf_lo(ug[k]) * m0 + pg8::bf_lo(bs[k]) * ya0, pg8::bf_hi(ug[k]) * m1 + pg8::bf_hi(bs[k]) * ya1);
            }
            *(u32x4*)(MRG + off) = o;
        }
    }
    __syncthreads();
}

__device__ __forceinline__ void fix_phase(const Params& P, int l) {
    const bf16_t* RAWB = (const bf16_t*)(P.ws + WS_RAWB); bf16_t* ACT = (bf16_t*)(P.ws + WS_ACT); const float* cw = P.conv_f + (size_t)l * 3 * NUP;
    constexpr int C8 = DFF / 8, NIT = (MTOK / 64) * 2 * C8;
    int tid_ = threadIdx.x; asm volatile("" : "+v"(tid_));
    for (int it = blockIdx.x * 512 + tid_; it < NIT; it += gridDim.x * 512) {
        const int c8 = it % C8, rr = (it / C8) & 1, grp = it / (2 * C8);
        const int ch = 8 * c8, pn = ch >> 7, i = ch & 127, gcol = 256 * pn + i;
        const bool start = ((grp * 64) % SEQ) == 0;
        float o[8];
        float yv[2][8];
#pragma unroll
        for (int h = 0; h < 2; ++h) {
            const int col = gcol + 128 * h; const int wc0 = h * DFF + ch;
            const u32x4 z = (u32x4){0u, 0u, 0u, 0u};
            const u32x4 x0 = *(const u32x4*)(RAWB + ((size_t)grp * 4 + rr) * NUP + col);
            u32x4 x1, x2;
            if (rr == 1) { x1 = *(const u32x4*)(RAWB + ((size_t)grp * 4 + 0) * NUP + col); x2 = start ? z : *(const u32x4*)(RAWB + ((size_t)(grp - 1) * 4 + 3) * NUP + col); }
            else { x1 = start ? z : *(const u32x4*)(RAWB + ((size_t)(grp - 1) * 4 + 3) * NUP + col); x2 = start ? z : *(const u32x4*)(RAWB + ((size_t)(grp - 1) * 4 + 2) * NUP + col); }
#pragma unroll
            for (int k = 0; k < 4; ++k) {
                const float w0a = cw[wc0 + 2 * k], w1a = cw[NUP + wc0 + 2 * k], w2a = cw[2 * NUP + wc0 + 2 * k];
                const float w0b = cw[wc0 + 2 * k + 1], w1b = cw[NUP + wc0 + 2 * k + 1], w2b = cw[2 * NUP + wc0 + 2 * k + 1];
                yv[h][2 * k] = w2a * pg8::bf_lo(x0[k]) + w1a * pg8::bf_lo(x1[k]) + w0a * pg8::bf_lo(x2[k]);
                yv[h][2 * k + 1] = w2b * pg8::bf_hi(x0[k]) + w1b * pg8::bf_hi(x1[k]) + w0b * pg8::bf_hi(x2[k]);
            }
        }
#pragma unroll
        for (int j = 0; j < 8; ++j) o[j] = yv[0][j] * pg8::sigmoid_f(yv[0][j]) * yv[1][j];
        u32x4 w; w.x = pk2(o[0], o[1]); w.y = pk2(o[2], o[3]); w.z = pk2(o[4], o[5]); w.w = pk2(o[6], o[7]);
        *(u32x4*)(ACT + ((size_t)grp * 64 + rr) * DFF + ch) = w;
    }
}

__device__ __forceinline__ void final_phase(const Params& P) {
    int tid_ = threadIdx.x; asm volatile("" : "+v"(tid_));
    const int lane = tid_ & 63, gw = blockIdx.x * 8 + (tid_ >> 6), NGW = gridDim.x * 8;
    const bf16_t* X = (const bf16_t*)(P.ws + WS_X); const float* xss = (const float*)(P.ws + WS_XSS);
    for (int m = gw; m < MTOK; m += NGW) {
        float s = lane < 16 ? xss[(size_t)m * 16 + lane] : 0.f; s = wave_sum(s);
        const float r = rsqrtf(s * (1.0f / DM) + EPS);
#pragma unroll
        for (int j = 0; j < 2; ++j) {
            const int c = 8 * lane + 512 * j;
            const u32x4 xv = *(const u32x4*)(X + (size_t)m * DM + c);
            const f32x4 g0 = *(const f32x4*)(P.fin_g + c), g1 = *(const f32x4*)(P.fin_g + c + 4);
            f32x4 o0, o1;
            o0[0] = pg8::bf_lo(xv.x) * r * g0[0]; o0[1] = pg8::bf_hi(xv.x) * r * g0[1]; o0[2] = pg8::bf_lo(xv.y) * r * g0[2]; o0[3] = pg8::bf_hi(xv.y) * r * g0[3];
            o1[0] = pg8::bf_lo(xv.z) * r * g1[0]; o1[1] = pg8::bf_hi(xv.z) * r * g1[1]; o1[2] = pg8::bf_lo(xv.w) * r * g1[2]; o1[3] = pg8::bf_hi(xv.w) * r * g1[3];
            *(f32x4*)(P.out + (size_t)m * DM + c) = o0; *(f32x4*)(P.out + (size_t)m * DM + c + 4) = o1;
        }
    }
}

__global__ void __launch_bounds__(512, 2) fwd_megakernel(Params P) {
    extern __shared__ __attribute__((aligned(16))) unsigned char lds_raw[];
    LAS unsigned char* lds = (LAS unsigned char*)lds_raw;
    cg::grid_group grid = cg::this_grid();
    const int G = gridDim.x;
    bf16_t* X = (bf16_t*)(P.ws + WS_X); float* xss = (float*)(P.ws + WS_XSS);
    p0_phase(P, lds);
    grid.sync();
#pragma unroll 1
    for (int l = 0; l < DEPTH; ++l) {
        {
            pg8::Gemm g{X, (const bf16_t*)(P.ws + WS_WIN) + (size_t)l * NIN * DM, MTOK, NIN, DM}; pg8::StaticOrder S; S.init(MTOK, NIN, G, (int)blockIdx.x);
            pg8::EpiIn E{xss, (bf16_t*)(P.ws + WS_CX), (bf16_t*)(P.ws + WS_V), (float*)(P.ws + WS_VST), (size_t)(WS_BSG - WS_CX) / 2};
            pg8::gemm_phase<pg8::EpiIn, pg8::StaticOrder>(lds, g, S, E, nullptr);
        }
        grid.sync();
        sgu_phase(P, lds, l);
        grid.sync();
        {
            pg8::Gemm g{(const bf16_t*)(P.ws + WS_MRG), (const bf16_t*)(P.ws + WS_WOUT) + (size_t)l * DM * DM, MTOK, DM, DM}; pg8::StaticOrder S; S.init(MTOK, DM, G, (int)blockIdx.x);
            pg8::EpiRes E{X, xss};
            pg8::gemm_phase<pg8::EpiRes, pg8::StaticOrder>(lds, g, S, E, nullptr);
        }
        grid.sync();
        {
            pg8::Gemm g{X, (const bf16_t*)(P.ws + WS_WUP) + (size_t)l * NUP * DM, MTOK, NUP, DM}; pg8::StaticOrder S; S.init(MTOK, NUP, G, (int)blockIdx.x);
            pg8::EpiUp E{xss, P.conv_f + (size_t)l * 3 * NUP, (bf16_t*)(P.ws + WS_ACT), (bf16_t*)(P.ws + WS_RAWB)};
            pg8::gemm_phase<pg8::EpiUp, pg8::StaticOrder>(lds, g, S, E, nullptr);
        }
        grid.sync();
        fix_phase(P, l);
        grid.sync();
        {
            pg8::Gemm g{(const bf16_t*)(P.ws + WS_ACT), (const bf16_t*)(P.ws + WS_WDN) + (size_t)l * DM * DFF, MTOK, DM, DFF}; pg8::StaticOrder S; S.init(MTOK, DM, G, (int)blockIdx.x);
            pg8::EpiRes E{X, xss};
            pg8::gemm_phase<pg8::EpiRes, pg8::StaticOrder>(lds, g, S, E, nullptr);
        }
        grid.sync();
    }
    final_phase(P);
}

extern "C" void kernel_launch(void* const* d_in, const int* in_sizes, int n_in, void* d_out, int out_size, void* d_ws, size_t ws_size, hipStream_t stream) {
    static int grid_blocks = 0;
    if (!grid_blocks) {
        int dev = 0, cus = 0, per_cu = 0;
        hipGetDevice(&dev);
        hipDeviceGetAttribute(&cus, hipDeviceAttributeMultiprocessorCount, dev);
        hipFuncSetAttribute((const void*)fwd_megakernel, hipFuncAttributeMaxDynamicSharedMemorySize, LDS_BYTES);
        hipOccupancyMaxActiveBlocksPerMultiprocessor(&per_cu, (const void*)fwd_megakernel, 512, LDS_BYTES);
        if (per_cu < 1) { fprintf(stderr, "occupancy query says %d blocks/CU\n", per_cu); per_cu = 1; }
        grid_blocks = cus * 1;
        if (ws_size < WS_END) fprintf(stderr, "workspace too small: %zu < %zu\n", ws_size, (size_t)WS_END);
    }
    Params p{};
    p.x = (const float*)d_in[0]; p.mix_g = (const float*)d_in[1]; p.w_in = (const float*)d_in[2]; p.conv_a = (const float*)d_in[3]; p.ln_g = (const float*)d_in[4]; p.ln_b = (const float*)d_in[5];
    p.w_s = (const float*)d_in[6]; p.b_s = (const float*)d_in[7]; p.w_out = (const float*)d_in[8]; p.ffn_g = (const float*)d_in[9]; p.w_up = (const float*)d_in[10]; p.conv_f = (const float*)d_in[11];
    p.w_dn = (const float*)d_in[12]; p.fin_g = (const float*)d_in[13]; p.out = (float*)d_out; p.ws = (unsigned char*)d_ws;
    void* args[] = {&p};
    hipError_t e = hipLaunchCooperativeKernel((const void*)fwd_megakernel, dim3(grid_blocks), dim3(512), args, LDS_BYTES, stream);
    if (e != hipSuccess) fprintf(stderr, "cooperative launch failed: %s (grid %d)\n", hipGetErrorString(e), grid_blocks);
}
```

```cpp
#include <hip/hip_runtime.h>
#include <hip/hip_cooperative_groups.h>
#include <cstdio>
namespace cg = cooperative_groups;
namespace pg8 {
#define PG8_LAS __attribute__((address_space(3)))
typedef unsigned short bf16_t;
typedef short bf16x8 __attribute__((ext_vector_type(8)));
typedef float f32x4 __attribute__((ext_vector_type(4)));
typedef unsigned u32x4 __attribute__((ext_vector_type(4)));
constexpr int BM = 256, BK = 64, HALF = 128, HTB = HALF * BK * 2  , STAGE_BYTES = 8 * HTB, NXCD = 8, WGM = 8;

__host__ __device__ __forceinline__ int lds_byte(int r, int c) { const int st = (r >> 4) * 2 + (c >> 5), rr = r & 15, cc = c & 31, ob = rr * 64 + cc * 2; return st * 1024 + (ob ^ (((ob >> 9) & 1) << 5)); }
__host__ __device__ __forceinline__ void stage_rc(int b, int& R, int& C) { const int st = b / 1024, sb = b % 1024, swz = sb ^ (((sb >> 9) & 1) << 5); R = (st >> 1) * 16 + swz / 64; C = (st & 1) * 32 + (swz % 64) / 2; }
__host__ __device__ __forceinline__ int perm32(int rho) { const int n = rho >> 4, i = rho & 15; return 8 * (i >> 2) + 4 * n + (i & 3); }

struct Unit { int pm, pn; };
struct Gemm { const bf16_t* A; const bf16_t* Bt; int M, N, K; };

struct StaticOrder {
    int nM, nN, nwg, G, c;
    __host__ __device__ void init(int M, int N, int G_, int c_) { nM = M / BM; nN = N / BM; nwg = nM * nN; G = G_; c = c_; }
    __host__ __device__ bool next(int i, Unit& u) const {
        const long L = (long)i * G + c; if (L >= nwg) return false;
        int wgid = (int)L; { const int q = nwg / NXCD, r = nwg % NXCD, xcd = wgid % NXCD, off = wgid / NXCD; wgid = (xcd < r ? xcd * (q + 1) : r * (q + 1) + (xcd - r) * q) + off; }
        const int nig = WGM * nN, gid = wgid / nig, fm = gid * WGM, gsz = (nM - fm) < WGM ? (nM - fm) : WGM;
        u.pm = fm + ((wgid % nig) % gsz); u.pn = (wgid % nig) / gsz; return true;
    }
    __device__ __forceinline__ void a_ready(const Unit&) const {}
    __device__ __forceinline__ void done(const Unit&) const {}
};
__device__ __forceinline__ unsigned cvt_pk_bf16(float lo, float hi) { unsigned r; asm volatile("v_cvt_pk_bf16_f32 %0, %1, %2" : "=v"(r) : "v"(lo), "v"(hi)); return r; }
constexpr int MTOK = 32 * 2048, DM = 1024, SEQ = 2048, NIN = 7168, DFF = 2816, NUP = 2 * DFF, DEPTH = 2;
constexpr float EPS = 1e-6f;
typedef unsigned u32x4 __attribute__((ext_vector_type(4)));
typedef float f32x2 __attribute__((ext_vector_type(2)));

__device__ __forceinline__ float bf_lo(unsigned w) { return __uint_as_float(w << 16); }
__device__ __forceinline__ float bf_hi(unsigned w) { return __uint_as_float(w & 0xffff0000u); }
__device__ __forceinline__ float sigmoid_f(float x) { return __builtin_amdgcn_rcpf(1.0f + __builtin_amdgcn_exp2f(-1.44269504f * x)); }
__device__ __forceinline__ float dpp_ror1(float v) { return __builtin_bit_cast(float, __builtin_amdgcn_update_dpp(0, __builtin_bit_cast(int, v), 0x121, 0xf, 0xf, true)); }
__device__ __forceinline__ float dpp_ror2(float v) { return __builtin_bit_cast(float, __builtin_amdgcn_update_dpp(0, __builtin_bit_cast(int, v), 0x122, 0xf, 0xf, true)); }

constexpr int RS_OFF = STAGE_BYTES, RS_SLOTS = 8;
template <class Sched> __device__ __forceinline__ int fill_rs(PG8_LAS unsigned char* lds, const Sched& S, const float* xss) {
    int tid = threadIdx.x; asm volatile("" : "+v"(tid));
    Unit u0, ul; if (!S.next(0, u0)) return 0;
    int n = 0; while (S.next(n, ul)) ++n;
    S.next(n - 1, ul);
    const int pm0 = u0.pm, nslots = ((ul.pm - pm0) >> 3) + 1;
    PG8_LAS float* RS = (PG8_LAS float*)(lds + RS_OFF);
    for (int idx = tid; idx < nslots * 256 && idx < RS_SLOTS * 256; idx += 512) {
        const int row = (pm0 + 8 * (idx >> 8)) * BM + (idx & 255);
        const f32x4* p = (const f32x4*)(xss + (size_t)row * 16);
        const f32x4 a = p[0], b = p[1], c = p[2], d = p[3];
        const float s = ((a[0] + a[1]) + (a[2] + a[3])) + ((b[0] + b[1]) + (b[2] + b[3])) + ((c[0] + c[1]) + (c[2] + c[3])) + ((d[0] + d[1]) + (d[2] + d[3]));
        RS[idx] = rsqrtf(s * (1.0f / DM) + EPS);
    }
    __syncthreads();
    return pm0;
}
__device__ __forceinline__ float row_rstd(const PG8_LAS float* rs, int r) { return rs[r]; }

struct EpiIn {
    static constexpr bool PERM = true, AFTER_DRAIN = false;
    const PG8_LAS float* RS; int pm0; bf16_t *CX  , *V; float* vst; size_t ostride;
    __device__ __forceinline__ void operator()(f32x4 (&acc)[2][2][4][2], const Unit& u, int wr, int wc, int fr_, int fq_) const {
        int fr = fr_, fq = fq_; asm volatile("" : "+v"(fr), "+v"(fq));
        const int row0 = u.pm * BM + wr * 64 + fr;
        const int type = u.pn >> 3;
        const PG8_LAS float* rsb = RS + ((u.pm - pm0) >> 3) * 256 + wr * 64 + fr;
        if (type == 3) {
            const int vt = u.pn - 24, col0 = vt * 256 + wc * 32 + 8 * fq;
#pragma unroll
            for (int ai = 0; ai < 2; ++ai)
#pragma unroll
                for (int m = 0; m < 4; ++m) {
                    const int row = row0 + ai * 128 + m * 16; const float r = rsb[ai * 128 + m * 16]; float s = 0.f, q = 0.f;
#pragma unroll
                    for (int bj = 0; bj < 2; ++bj) {
                        const f32x4 v0 = acc[ai][bj][m][0] * r, v1 = acc[ai][bj][m][1] * r;
                        u32x4 w; w.x = cvt_pk_bf16(v0[0], v0[1]); w.y = cvt_pk_bf16(v0[2], v0[3]); w.z = cvt_pk_bf16(v1[0], v1[1]); w.w = cvt_pk_bf16(v1[2], v1[3]);
                        *(u32x4*)((char*)V + (unsigned)((row * DM + col0 + bj * HALF) * 2)) = w;
#pragma unroll
                        for (int k = 0; k < 4; ++k) { const float a = bf_lo(w[k]), b = bf_hi(w[k]); s += a + b; q += a * a + b * b; }
                    }
                    s += __shfl_xor(s, 16); s += __shfl_xor(s, 32); q += __shfl_xor(q, 16); q += __shfl_xor(q, 32);
                    if (fq == 0) *(f32x2*)((char*)vst + (unsigned)((row * 16 + vt * 4 + wc) * 8)) = (f32x2){s, q};
                }
        } else {
            bf16_t* O = CX + (size_t)type * ostride;
            const int col0 = (u.pn & 7) * 128 + wc * 32 + 8 * fq;
#pragma unroll
            for (int ai = 0; ai < 2; ++ai)
#pragma unroll
                for (int m = 0; m < 4; ++m) {
                    const int row = row0 + ai * 128 + m * 16; const float r = rsb[ai * 128 + m * 16];
                    f32x4 o[2];
#pragma unroll
                    for (int n = 0; n < 2; ++n) {
                        const f32x4 a = acc[ai][0][m][n] * r, b = acc[ai][1][m][n] * r;
                        if (type == 0) o[n] = a * b;
                        else { o[n][0] = a[0] * sigmoid_f(b[0]); o[n][1] = a[1] * sigmoid_f(b[1]); o[n][2] = a[2] * sigmoid_f(b[2]); o[n][3] = a[3] * sigmoid_f(b[3]); }
                    }
                    u32x4 w; w.x = cvt_pk_bf16(o[0][0], o[0][1]); w.y = cvt_pk_bf16(o[0][2], o[0][3]); w.z = cvt_pk_bf16(o[1][0], o[1][1]); w.w = cvt_pk_bf16(o[1][2], o[1][3]);
                    *(u32x4*)((char*)O + (unsigned)((row * DM + col0) * 2)) = w;
                }
        }
    }
};

struct EpiRes {
    static constexpr bool PERM = true, AFTER_DRAIN = false;
    bf16_t* X; float* xss;
    __device__ __forceinline__ void operator()(f32x4 (&acc)[2][2][4][2], const Unit& u, int wr, int wc, int fr_, int fq_) const {
        int fr = fr_, fq = fq_; asm volatile("" : "+v"(fr), "+v"(fq));
        const int row0 = u.pm * BM + wr * 64 + fr, col0 = u.pn * BM + wc * 32 + 8 * fq;
#pragma unroll
        for (int ai = 0; ai < 2; ++ai)
#pragma unroll
            for (int m = 0; m < 4; ++m) {
                const int row = row0 + ai * 128 + m * 16; float q = 0.f;
#pragma unroll
                for (int bj = 0; bj < 2; ++bj) {
                    u32x4* p = (u32x4*)((char*)X + (unsigned)((row * DM + col0 + bj * HALF) * 2));
                    const u32x4 old = *p; const f32x4 a0 = acc[ai][bj][m][0], a1 = acc[ai][bj][m][1];
                    u32x4 w;
                    w.x = cvt_pk_bf16(bf_lo(old.x) + a0[0], bf_hi(old.x) + a0[1]); w.y = cvt_pk_bf16(bf_lo(old.y) + a0[2], bf_hi(old.y) + a0[3]);
                    w.z = cvt_pk_bf16(bf_lo(old.z) + a1[0], bf_hi(old.z) + a1[1]); w.w = cvt_pk_bf16(bf_lo(old.w) + a1[2], bf_hi(old.w) + a1[3]);
                    *p = w;
#pragma unroll
                    for (int k = 0; k < 4; ++k) { const float a = bf_lo(w[k]), b = bf_hi(w[k]); q += a * a + b * b; }
                }
                q += __shfl_xor(q, 16); q += __shfl_xor(q, 32);
                if (fq == 0) *(float*)((char*)xss + (unsigned)((row * 16 + u.pn * 4 + wc) * 4)) = q;
            }
    }
};

__device__ __forceinline__ f32x4 ror1_4(f32x4 v) { return (f32x4){dpp_ror1(v[0]), dpp_ror1(v[1]), dpp_ror1(v[2]), dpp_ror1(v[3])}; }
__device__ __forceinline__ f32x4 ror2_4(f32x4 v) { return (f32x4){dpp_ror2(v[0]), dpp_ror2(v[1]), dpp_ror2(v[2]), dpp_ror2(v[3])}; }
__device__ __forceinline__ f32x4 sel4(bool c, f32x4 a, f32x4 b) { return (f32x4){c ? a[0] : b[0], c ? a[1] : b[1], c ? a[2] : b[2], c ? a[3] : b[3]}; }
struct EpiUp {
    static constexpr bool PERM = true, AFTER_DRAIN = false;
    const PG8_LAS float* RS; int pm0; const float* cw  ; bf16_t* ACT; bf16_t* RAWB  ;
    __device__ __forceinline__ void operator()(f32x4 (&acc)[2][2][4][2], const Unit& u, int wr, int wc, int fr_, int fq_) const {
        int fr = fr_, fq = fq_; asm volatile("" : "+v"(fr), "+v"(fq));
        const int row0 = u.pm * BM + wr * 64 + fr;
        const int tc0 = wc * 32 + 8 * fq;
        const PG8_LAS float* rsb = RS + ((u.pm - pm0) >> 3) * 256 + wr * 64 + fr;
#pragma unroll
        for (int ai = 0; ai < 2; ++ai)
#pragma unroll
            for (int m = 0; m < 4; ++m) {
                const float r = rsb[ai * 128 + m * 16];
#pragma unroll
                for (int bj = 0; bj < 2; ++bj) { acc[ai][bj][m][0] *= r; acc[ai][bj][m][1] *= r; }
                if (m == 0 || m == 3) {
                    const bool sv = (m == 0) ? (fr < 2) : (fr >= 14);
                    if (sv) {
                        const int grp = (u.pm * BM + ai * 128 + wr * 64) >> 6, slot = (m == 0) ? fr : (fr - 12);
#pragma unroll
                        for (int bj = 0; bj < 2; ++bj) {
                            const f32x4 v0 = acc[ai][bj][m][0], v1 = acc[ai][bj][m][1];
                            u32x4 w; w.x = cvt_pk_bf16(v0[0], v0[1]); w.y = cvt_pk_bf16(v0[2], v0[3]); w.z = cvt_pk_bf16(v1[0], v1[1]); w.w = cvt_pk_bf16(v1[2], v1[3]);
                            *(u32x4*)((char*)RAWB + (unsigned)(((grp * 4 + slot) * NUP + u.pn * 256 + bj * HALF + tc0) * 2)) = w;
                        }
                    }
                }
            }
        const bool f1 = fr >= 1, f2 = fr >= 2;
        const f32x4 zero4 = (f32x4){0.f, 0.f, 0.f, 0.f};
#pragma unroll
        for (int n = 0; n < 2; ++n) {
            f32x4 w[2][3];
#pragma unroll
            for (int bj = 0; bj < 2; ++bj)
#pragma unroll
                for (int t = 0; t < 3; ++t) w[bj][t] = *(const f32x4*)((const char*)cw + (unsigned)((t * NUP + bj * DFF + u.pn * 128 + tc0 + 4 * n) * 4));
#pragma unroll
            for (int ai = 0; ai < 2; ++ai) {
                f32x4 y[2][4];
#pragma unroll
                for (int bj = 0; bj < 2; ++bj) {
                    f32x4 a1n = ror1_4(acc[ai][bj][3][n]), a2n = ror2_4(acc[ai][bj][3][n]);
#pragma unroll
                    for (int m = 3; m >= 0; --m) {
                        const f32x4 a1 = a1n, a2 = a2n;
                        if (m > 0) { a1n = ror1_4(acc[ai][bj][m - 1][n]); a2n = ror2_4(acc[ai][bj][m - 1][n]); } else { a1n = zero4; a2n = zero4; }
                        y[bj][m] = w[bj][2] * acc[ai][bj][m][n] + w[bj][1] * sel4(f1, a1, a1n) + w[bj][0] * sel4(f2, a2, a2n);
                    }
                }
#pragma unroll
                for (int m = 0; m < 4; ++m) {
                    const int row = row0 + ai * 128 + m * 16;
                    const f32x4 g = y[0][m], v = y[1][m];
                    const unsigned lo = cvt_pk_bf16(g[0] * sigmoid_f(g[0]) * v[0], g[1] * sigmoid_f(g[1]) * v[1]), hi = cvt_pk_bf16(g[2] * sigmoid_f(g[2]) * v[2], g[3] * sigmoid_f(g[3]) * v[3]);
                    *(unsigned long long*)((char*)ACT + (unsigned)((row * DFF + u.pn * 128 + tc0 + 4 * n) * 2)) = (unsigned long long)lo | ((unsigned long long)hi << 32);
                }
            }
        }
    }
};
template <class Epi, class Sched, bool STAMP = false>
__device__ __forceinline__ void gemm_phase(PG8_LAS unsigned char* lds, const Gemm g, const Sched& S, const Epi& E, unsigned long long* stamps) {
    int tid_ = threadIdx.x; asm volatile("" : "+v"(tid_));
    const int tid = tid_, wid = __builtin_amdgcn_readfirstlane(tid >> 6), lane = tid & 63, wr = wid >> 2, wc = wid & 3, fr = lane & 15, fq = lane >> 4;
    const int K = g.K, nt = K / BK;
    int ts_lo = 0, ts_hi = 0, nts = 0; const unsigned long long rt_entry = STAMP ? (unsigned long long)wall_clock64() : 0ull;
#define PG8_STAMP() do { if (STAMP && wid == 0 && nts < 64) { const unsigned long long _c = (unsigned long long)clock64(); \
        ts_lo = (lane == nts) ? (int)(unsigned)_c : ts_lo; ts_hi = (lane == nts) ? (int)(unsigned)(_c >> 32) : ts_hi; ++nts; } } while (0)
    PG8_STAMP();
    unsigned voffA[2], voffB[2];
#pragma unroll
    for (int i = 0; i < 2; ++i) { int R, C; stage_rc(tid * 16 + i * 8192, R, C); const int Rb = Epi::PERM ? ((R & ~31) + perm32(R & 31)) : R;
        voffA[i] = (unsigned)(R * K + C) * 2u; voffB[i] = (unsigned)(Rb * K + C) * 2u; }
    const size_t kstep = (size_t)(BK * 2);
    const size_t hstep = (size_t)HALF * K * 2;
    const size_t tstep = 2 * hstep;
    const unsigned ldsw = (unsigned)wid * 1024u;
    const int aoff = lds_byte(wr * 64 + fr, fq * 8), boff = lds_byte(wc * 32 + fr, fq * 8);
#define PG8_SA(b, h) (((b) * 2 + (h)) * HTB)
#define PG8_SB(b, h) ((4 + (b) * 2 + (h)) * HTB)
#define PG8_STAGE(bufoff, gbase, voff) do { _Pragma("unroll") for (int _i = 0; _i < 2; ++_i) \
        __builtin_amdgcn_global_load_lds((const unsigned*)((const char*)(gbase) + (voff)[_i]), (PG8_LAS unsigned*)(lds + (bufoff) + ldsw + _i * 8192), 16, 0, 0); } while (0)
#define PG8_LDA(dst, b, h) do { _Pragma("unroll") for (int m = 0; m < 4; ++m) _Pragma("unroll") for (int k = 0; k < 2; ++k) dst[m][k] = *(const PG8_LAS bf16x8*)(lds + PG8_SA(b, h) + aoff + m * 2048 + k * 1024); } while (0)
#define PG8_LDB(dst, b, h) do { _Pragma("unroll") for (int n = 0; n < 2; ++n) _Pragma("unroll") for (int k = 0; k < 2; ++k) dst[n][k] = *(const PG8_LAS bf16x8*)(lds + PG8_SB(b, h) + boff + n * 2048 + k * 1024); } while (0)
#define PG8_MMA(ai, bj, At, Bt) do { __builtin_amdgcn_s_setprio(1); _Pragma("unroll") for (int m = 0; m < 4; ++m) _Pragma("unroll") for (int n = 0; n < 2; ++n) _Pragma("unroll") for (int k = 0; k < 2; ++k) \
        acc[ai][bj][m][n] = __builtin_amdgcn_mfma_f32_16x16x32_bf16(Bt[n][k], At[m][k], acc[ai][bj][m][n], 0, 0, 0); __builtin_amdgcn_s_setprio(0); } while (0)
#define PG8_WAIT_V(n) asm volatile("s_waitcnt vmcnt(" #n ")" ::: "memory")
#define PG8_WAIT_L(n) asm volatile("s_waitcnt lgkmcnt(" #n ")" ::: "memory")
#define PG8_BAR __builtin_amdgcn_s_barrier()
#define PG8_SCHED __builtin_amdgcn_sched_barrier(0)
    Unit cur, nxt; int ui = 0;
    if (!S.next(0, cur)) return;
    f32x4 acc[2][2][4][2];
#pragma unroll
    for (int a = 0; a < 2; ++a)
#pragma unroll
        for (int b = 0; b < 2; ++b)
#pragma unroll
            for (int m = 0; m < 4; ++m)
#pragma unroll
                for (int n = 0; n < 2; ++n) acc[a][b][m][n] = (f32x4){0.f, 0.f, 0.f, 0.f};
    bf16x8 At[4][2], B0[2][2], B1[2][2];
    const char* cA = (const char*)g.A + (size_t)cur.pm * tstep; const char* cB = (const char*)g.Bt + (size_t)cur.pn * tstep;
    S.a_ready(cur);
    PG8_STAGE(PG8_SB(0, 0), cB, voffB); PG8_STAGE(PG8_SA(0, 0), cA, voffA); PG8_STAGE(PG8_SB(0, 1), cB + hstep, voffB); PG8_STAGE(PG8_SA(0, 1), cA + hstep, voffA);
    if (wr == 1) PG8_BAR;
    PG8_WAIT_V(4); PG8_BAR;
    PG8_STAGE(PG8_SB(1, 0), cB + kstep, voffB); PG8_STAGE(PG8_SA(1, 0), cA + kstep, voffA); PG8_STAGE(PG8_SB(1, 1), cB + hstep + kstep, voffB);
    PG8_WAIT_V(6); PG8_BAR;
    PG8_STAMP();
    for (;;) {
        const bool has_next = S.next(ui + 1, nxt);
        const char* nA = has_next ? (const char*)g.A + (size_t)nxt.pm * tstep : cA; const char* nB = has_next ? (const char*)g.Bt + (size_t)nxt.pn * tstep : cB;
        for (int t = 0; t < nt; t += 2) {
            const bool last = (t == nt - 2);
            const char* a1 = cA + (size_t)(t + 1) * kstep;
            const char* a2 = last ? nA : cA + (size_t)(t + 2) * kstep; const char* b2 = last ? nB : cB + (size_t)(t + 2) * kstep;
            const char* a3 = a2 + kstep; const char* b3 = b2 + kstep;
            if (last && has_next) S.a_ready(nxt);
            PG8_LDB(B0, 0, 0); PG8_SCHED; PG8_LDA(At, 0, 0); PG8_STAGE(PG8_SA(1, 1), a1 + hstep, voffA);
            PG8_WAIT_L(8); PG8_BAR; PG8_WAIT_L(0); PG8_MMA(0, 0, At, B0); PG8_BAR; PG8_SCHED;
            PG8_LDB(B1, 0, 1); PG8_STAGE(PG8_SB(0, 0), b2, voffB);
            PG8_BAR; PG8_WAIT_L(0); PG8_MMA(0, 1, At, B1); PG8_BAR;
            PG8_LDA(At, 0, 1); PG8_STAGE(PG8_SA(0, 0), a2, voffA);
            PG8_BAR; PG8_WAIT_L(0); PG8_MMA(1, 0, At, B0); PG8_BAR; PG8_SCHED;
            PG8_STAGE(PG8_SB(0, 1), b2 + hstep, voffB);
            PG8_WAIT_V(6); PG8_BAR; PG8_MMA(1, 1, At, B1); PG8_BAR;
            PG8_LDB(B0, 1, 0); PG8_SCHED; PG8_LDA(At, 1, 0); PG8_STAGE(PG8_SA(0, 1), a2 + hstep, voffA);
            PG8_WAIT_L(8); PG8_BAR; PG8_WAIT_L(0); PG8_MMA(0, 0, At, B0); PG8_BAR; PG8_SCHED;
            PG8_LDB(B1, 1, 1); PG8_STAGE(PG8_SB(1, 0), b3, voffB);
            PG8_BAR; PG8_WAIT_L(0); PG8_MMA(0, 1, At, B1); PG8_BAR;
            PG8_LDA(At, 1, 1); PG8_STAGE(PG8_SA(1, 0), a3, voffA);
            PG8_BAR; PG8_WAIT_L(0); PG8_MMA(1, 0, At, B0); PG8_BAR; PG8_SCHED;
            PG8_STAGE(PG8_SB(1, 1), b3 + hstep, voffB);
            PG8_WAIT_V(6); PG8_BAR; PG8_MMA(1, 1, At, B1); PG8_BAR;
        }
        PG8_STAMP();
        if constexpr (!Epi::AFTER_DRAIN) { E(acc, cur, wr, wc, fr, fq); S.done(cur); }
        PG8_STAMP();
        if (!has_next) break;
#pragma unroll
        for (int a = 0; a < 2; ++a)
#pragma unroll
            for (int b = 0; b < 2; ++b)
#pragma unroll
                for (int m = 0; m < 4; ++m)
#pragma unroll
                    for (int n = 0; n < 2; ++n) acc[a][b][m][n] = (f32x4){0.f, 0.f, 0.f, 0.f};
        cur = nxt; cA = nA; cB = nB; ++ui;
    }
    PG8_WAIT_V(0);
    if (wr == 0) PG8_BAR;
    PG8_BAR;
    if constexpr (Epi::AFTER_DRAIN) { E.fused(acc, cur, wr, wc, fr, fq, lds, wid, lane); S.done(cur); }
    PG8_STAMP();
    if (STAMP && wid == 0) { stamps[lane] = lane < nts ? (((unsigned long long)(unsigned)ts_hi << 32) | (unsigned)ts_lo) : 0ull;
        if (lane == 62) stamps[62] = rt_entry; if (lane == 63) stamps[63] = (unsigned long long)wall_clock64(); }
#undef PG8_STAMP
#undef PG8_SA
#undef PG8_SB
#undef PG8_STAGE
#undef PG8_LDA
#undef PG8_LDB
#undef PG8_MMA
#undef PG8_WAIT_V
#undef PG8_WAIT_L
#undef PG8_BAR
#undef PG8_SCHED
}
}
using pg8::bf16_t; using pg8::f32x4; using pg8::bf16x8; using pg8::u32x4; using pg8::f32x2;
using pg8::MTOK; using pg8::DM; using pg8::SEQ; using pg8::NIN; using pg8::DFF; using pg8::NUP; using pg8::DEPTH; using pg8::EPS;
#define LAS __attribute__((address_space(3)))

constexpr size_t MiB = 1u << 20;
constexpr size_t WS_WIN = 0;
constexpr size_t WS_WOUT = 28 * MiB;
constexpr size_t WS_WUP = 32 * MiB;
constexpr size_t WS_WDN = 54 * MiB;
constexpr size_t WS_XSS = 66 * MiB;
constexpr size_t WS_VST = 70 * MiB;
constexpr size_t WS_RAWB = 78 * MiB;
constexpr size_t WS_X = 128 * MiB;
constexpr size_t WS_CX = 256 * MiB, WS_BSG = 384 * MiB, WS_UG = 512 * MiB, WS_V = 640 * MiB;
constexpr size_t WS_ACT = 256 * MiB;
constexpr size_t WS_MRG = 768 * MiB;
constexpr size_t WS_END = 896 * MiB;
constexpr int LDS_BYTES = 131072 + 8192;

#ifndef DUP_P0
#define DUP_P0 1
#endif
#ifndef DUP_GIN
#define DUP_GIN 1
#endif
#ifndef DUP_SGU
#define DUP_SGU 1
#endif
#ifndef DUP_GUP
#define DUP_GUP 1
#endif
#ifndef DUP_FIX
#define DUP_FIX 1
#endif
#ifndef DUP_FIN
#define DUP_FIN 1
#endif
#ifndef DUP_SYNC
#define DUP_SYNC 1
#endif
struct Params {
    const float *x, *mix_g, *w_in, *conv_a, *ln_g, *ln_b, *w_s, *b_s, *w_out, *ffn_g, *w_up, *conv_f, *w_dn, *fin_g;
    float* out; unsigned char* ws;
};

__device__ __forceinline__ unsigned f2bf(float f) { unsigned u = __float_as_uint(f); return (u + 0x7fffu + ((u >> 16) & 1u)) >> 16; }
__device__ __forceinline__ unsigned pk2(float lo, float hi) { return pg8::cvt_pk_bf16(lo, hi); }
__device__ __forceinline__ float wave_sum(float v) {
#pragma unroll
    for (int o = 1; o < 64; o <<= 1) v += __shfl_xor(v, o);
    return v;
}

__device__ __forceinline__ void p0_item(const float* W, int N, int K, const float* gk, bf16_t* WT, int k0, int srccol, int dstrow, LAS float* scr, int lane) {
#pragma unroll 8
    for (int i = 0; i < 32; ++i) { const int kk = 2 * i + (lane >> 5); float v = W[(size_t)(k0 + kk) * N + srccol + (lane & 31)]; if (gk) v *= gk[k0 + kk]; scr[kk * 33 + (lane & 31)] = v; }
    asm volatile("s_waitcnt lgkmcnt(0)" ::: "memory");
    const int c = lane & 7;
#pragma unroll
    for (int j = 0; j < 4; ++j) { const int n = (lane >> 3) + 8 * j; const LAS float* s = scr + (8 * c) * 33 + n;
        u32x4 o; o.x = pk2(s[0 * 33], s[1 * 33]); o.y = pk2(s[2 * 33], s[3 * 33]); o.z = pk2(s[4 * 33], s[5 * 33]); o.w = pk2(s[6 * 33], s[7 * 33]);
        *(u32x4*)(WT + (size_t)(dstrow + n) * K + k0 + 8 * c) = o; }
    asm volatile("s_waitcnt lgkmcnt(0)" ::: "memory");
}
__device__ __forceinline__ int in_srccol(int np) {
    const int pn = np >> 8, r = np & 255, type = pn >> 3, cb = pn & 7, h = r >> 7, i = r & 127;
    if (type == 0) return (h ? 2048 : 1024) + 128 * cb + i;
    if (type == 1) return (h ? 5120 : 0) + 128 * cb + i;
    if (type == 2) return (h ? 6144 : 3072) + 128 * cb + i;
    return 4096 + 256 * (pn - 24) + r;
}
__device__ __forceinline__ int up_srccol(int np) { const int pn = np >> 8, r = np & 255; return ((r >> 7) ? DFF : 0) + 128 * pn + (r & 127); }

__device__ __forceinline__ void p0_phase(const Params& P, LAS unsigned char* lds) {
    int tid_ = threadIdx.x; asm volatile("" : "+v"(tid_));
    const int tid = tid_, lane = tid & 63, wave = tid >> 6;
    LAS float* scr = (LAS float*)(lds + wave * 16384);
    const int gw = blockIdx.x * 8 + wave, NGW = gridDim.x * 8;
    constexpr int I_IN = 16 * (NIN / 32), I_OUT = 16 * (DM / 32), I_UP = 16 * (NUP / 32), I_DN = (DFF / 64) * (DM / 32);
    constexpr int PER_L = I_IN + I_OUT + I_UP + I_DN;
    bf16_t* WIN = (bf16_t*)(P.ws + WS_WIN); bf16_t* WOUT = (bf16_t*)(P.ws + WS_WOUT); bf16_t* WUP = (bf16_t*)(P.ws + WS_WUP); bf16_t* WDN = (bf16_t*)(P.ws + WS_WDN);
    for (int it = gw; it < DEPTH * PER_L; it += NGW) {
        const int l = it / PER_L; int r = it % PER_L;
        if (r < I_IN) { const int kb = r / (NIN / 32), nb = r % (NIN / 32); p0_item(P.w_in + (size_t)l * DM * NIN, NIN, DM, P.mix_g + l * DM, WIN + (size_t)l * NIN * DM, 64 * kb, in_srccol(32 * nb), 32 * nb, scr, lane); continue; } r -= I_IN;
        if (r < I_OUT) { const int kb = r / (DM / 32), nb = r % (DM / 32); p0_item(P.w_out + (size_t)l * DM * DM, DM, DM, nullptr, WOUT + (size_t)l * DM * DM, 64 * kb, 32 * nb, 32 * nb, scr, lane); continue; } r -= I_OUT;
        if (r < I_UP) { const int kb = r / (NUP / 32), nb = r % (NUP / 32); p0_item(P.w_up + (size_t)l * DM * NUP, NUP, DM, P.ffn_g + l * DM, WUP + (size_t)l * NUP * DM, 64 * kb, up_srccol(32 * nb), 32 * nb, scr, lane); continue; } r -= I_UP;
        { const int kb = r / (DM / 32), nb = r % (DM / 32); p0_item(P.w_dn + (size_t)l * DFF * DM, DM, DFF, nullptr, WDN + (size_t)l * DM * DFF, 64 * kb, 32 * nb, 32 * nb, scr, lane); }
    }
    bf16_t* X = (bf16_t*)(P.ws + WS_X); float* xss = (float*)(P.ws + WS_XSS);
    for (int m0 = gw * 4; m0 < MTOK; m0 += NGW * 4) {
        f32x4 v[4][4];
#pragma unroll
        for (int r = 0; r < 4; ++r)
#pragma unroll
            for (int j = 0; j < 4; ++j) v[r][j] = ((const f32x4*)(P.x + (size_t)(m0 + r) * DM) + lane)[64 * j];
        float s[4];
#pragma unroll
        for (int r = 0; r < 4; ++r) {
            unsigned long long* o8 = (unsigned long long*)(X + (size_t)(m0 + r) * DM) + lane; s[r] = 0.f;
#pragma unroll
            for (int j = 0; j < 4; ++j) { const unsigned a = pk2(v[r][j][0], v[r][j][1]), b = pk2(v[r][j][2], v[r][j][3]);
                o8[64 * j] = (unsigned long long)a | ((unsigned long long)b << 32);
                const float f0 = pg8::bf_lo(a), f1 = pg8::bf_hi(a), f2 = pg8::bf_lo(b), f3 = pg8::bf_hi(b); s[r] += (f0 * f0 + f1 * f1) + (f2 * f2 + f3 * f3); }
        }
#pragma unroll
        for (int r = 0; r < 4; ++r) { const float t = wave_sum(s[r]); if (lane < 16) xss[(size_t)(m0 + r) * 16 + lane] = lane == 0 ? t : 0.f; }
    }
}

__device__ __forceinline__ int vt_key(int rho) { return ((rho >> 2) & 3) | (((rho >> 5) & 3) << 2); }
__device__ __forceinline__ void sgu_phase(const Params& P, LAS unsigned char* lds, int l) {
    int tid_ = threadIdx.x; asm volatile("" : "+v"(tid_));
    const int tid = tid_, lane = tid & 63, w = __builtin_amdgcn_readfirstlane(tid >> 6), fr = lane & 15, fq = lane >> 4;
    const int g = blockIdx.x & 7;
    LAS unsigned* WS = (LAS unsigned*)lds;
    LAS unsigned* VT = (LAS unsigned*)(lds + 32768);
    LAS f32x2* ST = (LAS f32x2*)(lds + 65536);
    LAS float* CW = (LAS float*)(lds + 65536 + 1024);
    const bf16_t* V = (const bf16_t*)(P.ws + WS_V); const bf16_t* UG = (const bf16_t*)(P.ws + WS_UG); const bf16_t* BSG = (const bf16_t*)(P.ws + WS_BSG); const bf16_t* CX = (const bf16_t*)(P.ws + WS_CX);
    bf16_t* MRG = (bf16_t*)(P.ws + WS_MRG); const float* vst = (const float*)(P.ws + WS_VST);
    __syncthreads();
    {
        const float* Wg = P.w_s + ((size_t)l * 8 + g) * 128 * 128;
#pragma unroll
        for (int i = 0; i < 4; ++i) { const int idx = tid + 512 * i, t = idx >> 4, s8 = idx & 15;
            const f32x4 a = *(const f32x4*)(Wg + t * 128 + 8 * s8), b = *(const f32x4*)(Wg + t * 128 + 8 * s8 + 4);
            float v[8] = {a[0], a[1], a[2], a[3], b[0], b[1], b[2], b[3]};
#pragma unroll
            for (int j = 0; j < 8; ++j) if (8 * s8 + j > t) v[j] = 0.f;
            u32x4 o; o.x = pk2(v[0], v[1]); o.y = pk2(v[2], v[3]); o.z = pk2(v[4], v[5]); o.w = pk2(v[6], v[7]);
            *(LAS u32x4*)(WS + t * 64 + ((4 * s8) ^ ((t & 15) << 2))) = o; }
        if (tid < 384) CW[tid] = P.conv_a[(size_t)l * 3 * DM + (tid >> 7) * DM + 128 * g + (tid & 127)];
    }
    const int c8 = tid & 15;
    float lg[8], lb[8];
#pragma unroll
    for (int j = 0; j < 8; ++j) { lg[j] = P.ln_g[l * DM + 128 * g + 8 * c8 + j]; lb[j] = P.ln_b[l * DM + 128 * g + 8 * c8 + j]; }
    const float bias = P.b_s[((size_t)l * 8 + g) * 128 + 16 * w + fr];
    for (int ck = blockIdx.x >> 3; ck < MTOK / 128; ck += gridDim.x >> 3) {
        const int row0 = ck * 128;
        __syncthreads();
        if (tid < 128) {
            const f32x4* p = (const f32x4*)(vst + (size_t)(row0 + tid) * 32); float s = 0.f, q = 0.f;
#pragma unroll
            for (int j = 0; j < 8; ++j) { const f32x4 v = p[j]; s += v[0] + v[2]; q += v[1] + v[3]; }
            const float mu = s * (1.0f / DM), var = q * (1.0f / DM) - mu * mu;
            ST[tid] = (f32x2){mu, rsqrtf(fmaxf(var, 0.f) + EPS)};
        }
        __syncthreads();
#pragma unroll
        for (int it = 0; it < 2; ++it) {
            const int sp = (tid >> 4) + 32 * it;
            const u32x4 v0 = *(const u32x4*)(V + (size_t)(row0 + 2 * sp) * DM + 128 * g + 8 * c8), v1 = *(const u32x4*)(V + (size_t)(row0 + 2 * sp + 1) * DM + 128 * g + 8 * c8);
            const f32x2 s0 = ST[2 * sp], s1 = ST[2 * sp + 1];
#pragma unroll
            for (int j = 0; j < 8; ++j) {
                const unsigned w0 = v0[j >> 1], w1 = v1[j >> 1];
                const float a = (j & 1) ? pg8::bf_hi(w0) : pg8::bf_lo(w0), b = (j & 1) ? pg8::bf_hi(w1) : pg8::bf_lo(w1);
                const float na = (a - s0[0]) * s0[1] * lg[j] + lb[j], nb = (b - s1[0]) * s1[1] * lg[j] + lb[j];
                const int rho = 32 * (c8 >> 2) + 16 * (j >> 2) + 4 * (c8 & 3) + (j & 3);
                VT[rho * 64 + (sp ^ (vt_key(rho) << 2))] = pk2(na, nb);
            }
        }
        __syncthreads();
        f32x4 acc[8];
#pragma unroll
        for (int nb = 0; nb < 8; ++nb) acc[nb] = (f32x4){0.f, 0.f, 0.f, 0.f};
        for (int kk = 0; kk <= (w >> 1); ++kk) {
            const bf16x8 wf = *(const LAS bf16x8*)(WS + (16 * w + fr) * 64 + ((16 * kk + 4 * fq) ^ (fr << 2)));
#pragma unroll
            for (int nb = 0; nb < 8; ++nb) { const int rho = 16 * nb + fr;
                const bf16x8 vf = *(const LAS bf16x8*)(VT + rho * 64 + ((16 * kk + 4 * fq) ^ (vt_key(rho) << 2)));
                acc[nb] = __builtin_amdgcn_mfma_f32_16x16x32_bf16(vf, wf, acc[nb], 0, 0, 0); }
        }
        const int t = 16 * w + fr; const size_t row = (size_t)row0 + t;
        const bool seq0 = (row0 % SEQ) == 0;
#pragma unroll
        for (int q = 0; q < 4; ++q) {
            const int ch = 32 * q + 8 * fq; const size_t off = row * DM + 128 * g + ch;
            const u32x4 ug = *(const u32x4*)(UG + off), bs = *(const u32x4*)(BSG + off), c0 = *(const u32x4*)(CX + off);
            u32x4 c1 = (u32x4){0u, 0u, 0u, 0u}, c2 = (u32x4){0u, 0u, 0u, 0u};
            if (!(seq0 && t < 1)) c1 = *(const u32x4*)(CX + off - DM);
            if (!(seq0 && t < 2)) c2 = *(const u32x4*)(CX + off - 2 * DM);
            u32x4 o;
#pragma unroll
            for (int k = 0; k < 4; ++k) {
                const int j0 = 2 * k, j1 = 2 * k + 1;
                const float m0 = acc[2 * q + (j0 >> 2)][j0 & 3] + bias, m1 = acc[2 * q + (j1 >> 2)][j1 & 3] + bias;
                const float ya0 = CW[256 + ch + j0] * pg8::bf_lo(c0[k]) + CW[128 + ch + j0] * pg8::bf_lo(c1[k]) + CW[ch + j0] * pg8::bf_lo(c2[k]);
                const float ya1 = CW[256 + ch + j1] * pg8::bf_hi(c0[k]) + CW[128 + ch + j1] * pg8::bf_hi(c1[k]) + CW[ch + j1] * pg8::bf_hi(c2[k]);
                o[k] = pk2(pg8::bf_lo(ug[k]) * m0 + pg8::bf_lo(bs[k]) * ya0, pg8::bf_hi(ug[k]) * m1 + pg8::bf_hi(bs[k]) * ya1);
            }
            *(u32x4*)(MRG + off) = o;
        }
    }
    __syncthreads();
}

__device__ __forceinline__ void fix_phase(const Params& P, int l) {
    const bf16_t* RAWB = (const bf16_t*)(P.ws + WS_RAWB); bf16_t* ACT = (bf16_t*)(P.ws + WS_ACT); const float* cw = P.conv_f + (size_t)l * 3 * NUP;
    constexpr int C8 = DFF / 8, NIT = (MTOK / 64) * 2 * C8;
    int tid_ = threadIdx.x; asm volatile("" : "+v"(tid_));
    for (int it = blockIdx.x * 512 + tid_; it < NIT; it += gridDim.x * 512) {
        const int c8 = it % C8, rr = (it / C8) & 1, grp = it / (2 * C8);
        const int ch = 8 * c8, pn = ch >> 7, i = ch & 127, gcol = 256 * pn + i;
        const bool start = ((grp * 64) % SEQ) == 0;
        float o[8];
        float yv[2][8];
#pragma unroll
        for (int h = 0; h < 2; ++h) {
            const int col = gcol + 128 * h; const int wc0 = h * DFF + ch;
            const u32x4 z = (u32x4){0u, 0u, 0u, 0u};
            const u32x4 x0 = *(const u32x4*)(RAWB + ((size_t)grp * 4 + rr) * NUP + col);
            u32x4 x1, x2;
            if (rr == 1) { x1 = *(const u32x4*)(RAWB + ((size_t)grp * 4 + 0) * NUP + col); x2 = start ? z : *(const u32x4*)(RAWB + ((size_t)(grp - 1) * 4 + 3) * NUP + col); }
            else { x1 = start ? z : *(const u32x4*)(RAWB + ((size_t)(grp - 1) * 4 + 3) * NUP + col); x2 = start ? z : *(const u32x4*)(RAWB + ((size_t)(grp - 1) * 4 + 2) * NUP + col); }
#pragma unroll
            for (int k = 0; k < 4; ++k) {
                const float w0a = cw[wc0 + 2 * k], w1a = cw[NUP + wc0 + 2 * k], w2a = cw[2 * NUP + wc0 + 2 * k];
                const float w0b = cw[wc0 + 2 * k + 1], w1b = cw[NUP + wc0 + 2 * k + 1], w2b = cw[2 * NUP + wc0 + 2 * k + 1];
                yv[h][2 * k] = w2a * pg8::bf_lo(x0[k]) + w1a * pg8::bf_lo(x1[k]) + w0a * pg8::bf_lo(x2[k]);
                yv[h][2 * k + 1] = w2b * pg8::bf_hi(x0[k]) + w1b * pg8::bf_hi(x1[k]) + w0b * pg8::bf_hi(x2[k]);
            }
        }
#pragma unroll
        for (int j = 0; j < 8; ++j) o[j] = yv[0][j] * pg8::sigmoid_f(yv[0][j]) * yv[1][j];
        u32x4 w; w.x = pk2(o[0], o[1]); w.y = pk2(o[2], o[3]); w.z = pk2(o[4], o[5]); w.w = pk2(o[6], o[7]);
        *(u32x4*)(ACT + ((size_t)grp * 64 + rr) * DFF + ch) = w;
    }
}

__device__ __forceinline__ void final_phase(const Params& P) {
    int tid_ = threadIdx.x; asm volatile("" : "+v"(tid_));
    const int lane = tid_ & 63, gw = blockIdx.x * 8 + (tid_ >> 6), NGW = gridDim.x * 8;
    const bf16_t* X = (const bf16_t*)(P.ws + WS_X); const float* xss = (const float*)(P.ws + WS_XSS);
    const f32x4 g00 = *(const f32x4*)(P.fin_g + 8 * lane), g01 = *(const f32x4*)(P.fin_g + 8 * lane + 4), g10 = *(const f32x4*)(P.fin_g + 8 * lane + 512), g11 = *(const f32x4*)(P.fin_g + 8 * lane + 516);
    for (int m0 = gw * 4; m0 < MTOK; m0 += NGW * 4) {
        u32x4 xv[4][2]; float s[4];
#pragma unroll
        for (int r = 0; r < 4; ++r) { s[r] = lane < 16 ? xss[(size_t)(m0 + r) * 16 + lane] : 0.f;
            xv[r][0] = *(const u32x4*)(X + (size_t)(m0 + r) * DM + 8 * lane); xv[r][1] = *(const u32x4*)(X + (size_t)(m0 + r) * DM + 8 * lane + 512); }
#pragma unroll
        for (int r = 0; r < 4; ++r) {
            const float rr = rsqrtf(wave_sum(s[r]) * (1.0f / DM) + EPS);
#pragma unroll
            for (int j = 0; j < 2; ++j) {
                const u32x4 x4 = xv[r][j]; const f32x4 ga = j ? g10 : g00, gb = j ? g11 : g01;
                f32x4 o0, o1;
                o0[0] = pg8::bf_lo(x4.x) * rr * ga[0]; o0[1] = pg8::bf_hi(x4.x) * rr * ga[1]; o0[2] = pg8::bf_lo(x4.y) * rr * ga[2]; o0[3] = pg8::bf_hi(x4.y) * rr * ga[3];
                o1[0] = pg8::bf_lo(x4.z) * rr * gb[0]; o1[1] = pg8::bf_hi(x4.z) * rr * gb[1]; o1[2] = pg8::bf_lo(x4.w) * rr * gb[2]; o1[3] = pg8::bf_hi(x4.w) * rr * gb[3];
                float* op = P.out + (size_t)(m0 + r) * DM + 8 * lane + 512 * j;
                *(f32x4*)op = o0; *(f32x4*)(op + 4) = o1;
            }
        }
    }
}

__global__ void __launch_bounds__(512, 2) fwd_megakernel(Params P) {
    extern __shared__ __attribute__((aligned(16))) unsigned char lds_raw[];
    LAS unsigned char* lds = (LAS unsigned char*)lds_raw;
    cg::grid_group grid = cg::this_grid();
    const int G = gridDim.x;
    bf16_t* X = (bf16_t*)(P.ws + WS_X); float* xss = (float*)(P.ws + WS_XSS);
    for (int d = 0; d < DUP_P0; ++d) { p0_phase(P, lds); for (int e = 0; e < DUP_SYNC; ++e) grid.sync(); }
#pragma unroll 1
    for (int l = 0; l < DEPTH; ++l) {
        for (int d = 0; d < DUP_GIN; ++d) {
            pg8::Gemm g{X, (const bf16_t*)(P.ws + WS_WIN) + (size_t)l * NIN * DM, MTOK, NIN, DM}; pg8::StaticOrder S; S.init(MTOK, NIN, G, (int)blockIdx.x);
            const int pm0 = pg8::fill_rs(lds, S, xss);
            pg8::EpiIn E{(const LAS float*)(lds + pg8::RS_OFF), pm0, (bf16_t*)(P.ws + WS_CX), (bf16_t*)(P.ws + WS_V), (float*)(P.ws + WS_VST), (size_t)(WS_BSG - WS_CX) / 2};
            pg8::gemm_phase<pg8::EpiIn, pg8::StaticOrder>(lds, g, S, E, nullptr);
        }
        grid.sync();
        for (int d = 0; d < DUP_SGU; ++d) sgu_phase(P, lds, l);
        grid.sync();
        {
            pg8::Gemm g{(const bf16_t*)(P.ws + WS_MRG), (const bf16_t*)(P.ws + WS_WOUT) + (size_t)l * DM * DM, MTOK, DM, DM}; pg8::StaticOrder S; S.init(MTOK, DM, G, (int)blockIdx.x);
            pg8::EpiRes E{X, xss};
            pg8::gemm_phase<pg8::EpiRes, pg8::StaticOrder>(lds, g, S, E, nullptr);
        }
        grid.sync();
        for (int d = 0; d < DUP_GUP; ++d) {
            pg8::Gemm g{X, (const bf16_t*)(P.ws + WS_WUP) + (size_t)l * NUP * DM, MTOK, NUP, DM}; pg8::StaticOrder S; S.init(MTOK, NUP, G, (int)blockIdx.x);
            const int pm0 = pg8::fill_rs(lds, S, xss);
            pg8::EpiUp E{(const LAS float*)(lds + pg8::RS_OFF), pm0, P.conv_f + (size_t)l * 3 * NUP, (bf16_t*)(P.ws + WS_ACT), (bf16_t*)(P.ws + WS_RAWB)};
            pg8::gemm_phase<pg8::EpiUp, pg8::StaticOrder>(lds, g, S, E, nullptr);
        }
        grid.sync();
        for (int d = 0; d < DUP_FIX; ++d) fix_phase(P, l);
        grid.sync();
        {
            pg8::Gemm g{(const bf16_t*)(P.ws + WS_ACT), (const bf16_t*)(P.ws + WS_WDN) + (size_t)l * DM * DFF, MTOK, DM, DFF}; pg8::StaticOrder S; S.init(MTOK, DM, G, (int)blockIdx.x);
            pg8::EpiRes E{X, xss};
            pg8::gemm_phase<pg8::EpiRes, pg8::StaticOrder>(lds, g, S, E, nullptr);
        }
        grid.sync();
    }
    for (int d = 0; d < DUP_FIN; ++d) final_phase(P);
}

extern "C" void kernel_launch(void* const* d_in, const int* in_sizes, int n_in, void* d_out, int out_size, void* d_ws, size_t ws_size, hipStream_t stream) {
    static int grid_blocks = 0;
    if (!grid_blocks) {
        int dev = 0, cus = 0, per_cu = 0;
        hipGetDevice(&dev);
        hipDeviceGetAttribute(&cus, hipDeviceAttributeMultiprocessorCount, dev);
        hipFuncSetAttribute((const void*)fwd_megakernel, hipFuncAttributeMaxDynamicSharedMemorySize, LDS_BYTES);
        hipOccupancyMaxActiveBlocksPerMultiprocessor(&per_cu, (const void*)fwd_megakernel, 512, LDS_BYTES);
        if (per_cu < 1) { fprintf(stderr, "occupancy query says %d blocks/CU\n", per_cu); per_cu = 1; }
        grid_blocks = cus * 1;
        if (ws_size < WS_END) fprintf(stderr, "workspace too small: %zu < %zu\n", ws_size, (size_t)WS_END);
    }
    Params p{};
    p.x = (const float*)d_in[0]; p.mix_g = (const float*)d_in[1]; p.w_in = (const float*)d_in[2]; p.conv_a = (const float*)d_in[3]; p.ln_g = (const float*)d_in[4]; p.ln_b = (const float*)d_in[5];
    p.w_s = (const float*)d_in[6]; p.b_s = (const float*)d_in[7]; p.w_out = (const float*)d_in[8]; p.ffn_g = (const float*)d_in[9]; p.w_up = (const float*)d_in[10]; p.conv_f = (const float*)d_in[11];
    p.w_dn = (const float*)d_in[12]; p.fin_g = (const float*)d_in[13]; p.out = (float*)d_out; p.ws = (unsigned char*)d_ws;
    void* args[] = {&p};
    hipError_t e = hipLaunchCooperativeKernel((const void*)fwd_megakernel, dim3(grid_blocks), dim3(512), args, LDS_BYTES, stream);
    if (e != hipSuccess) fprintf(stderr, "cooperative launch failed: %s (grid %d)\n", hipGetErrorString(e), grid_blocks);
}
```

```cpp
#define STAG_TICKS 0
#include <hip/hip_runtime.h>
#include <hip/hip_cooperative_groups.h>
#include <cstdio>
namespace cg = cooperative_groups;
namespace pg8 {
#define PG8_LAS __attribute__((address_space(3)))
typedef unsigned short bf16_t;
typedef short bf16x8 __attribute__((ext_vector_type(8)));
typedef float f32x4 __attribute__((ext_vector_type(4)));
typedef unsigned u32x4 __attribute__((ext_vector_type(4)));
constexpr int BM = 256, BK = 64, HALF = 128, HTB = HALF * BK * 2  , STAGE_BYTES = 8 * HTB, NXCD = 8, WGM = 8;

__host__ __device__ __forceinline__ int lds_byte(int r, int c) { const int st = (r >> 4) * 2 + (c >> 5), rr = r & 15, cc = c & 31, ob = rr * 64 + cc * 2; return st * 1024 + (ob ^ (((ob >> 9) & 1) << 5)); }
__host__ __device__ __forceinline__ void stage_rc(int b, int& R, int& C) { const int st = b / 1024, sb = b % 1024, swz = sb ^ (((sb >> 9) & 1) << 5); R = (st >> 1) * 16 + swz / 64; C = (st & 1) * 32 + (swz % 64) / 2; }
__host__ __device__ __forceinline__ int perm32(int rho) { const int n = rho >> 4, i = rho & 15; return 8 * (i >> 2) + 4 * n + (i & 3); }

struct Unit { int pm, pn; };
struct Gemm { const bf16_t* A; const bf16_t* Bt; int M, N, K, lda; };

struct StaticOrder {
    int nM, nN, nwg, G, c;
    __host__ __device__ void init(int M, int N, int G_, int c_) { nM = M / BM; nN = N / BM; nwg = nM * nN; G = G_; c = c_; }
    __host__ __device__ bool next(int i, Unit& u) const {
        const long L = (long)i * G + c; if (L >= nwg) return false;
        int wgid = (int)L; { const int q = nwg / NXCD, r = nwg % NXCD, xcd = wgid % NXCD, off = wgid / NXCD; wgid = (xcd < r ? xcd * (q + 1) : r * (q + 1) + (xcd - r) * q) + off; }
        const int nig = WGM * nN, gid = wgid / nig, fm = gid * WGM, gsz = (nM - fm) < WGM ? (nM - fm) : WGM;
        u.pm = fm + ((wgid % nig) % gsz); u.pn = (wgid % nig) / gsz; return true;
    }
    __device__ __forceinline__ void a_ready(const Unit&) const {}
    __device__ __forceinline__ void done(const Unit&) const {}
};
__device__ __forceinline__ unsigned cvt_pk_bf16(float lo, float hi) { unsigned r; asm volatile("v_cvt_pk_bf16_f32 %0, %1, %2" : "=v"(r) : "v"(lo), "v"(hi)); return r; }
constexpr int MTOK = 32 * 2048, DM = 1024, SEQ = 2048, NIN = 7168, DFF = 2816, NUP = 2 * DFF, DEPTH = 2;
#ifndef LDACT
#define LDACT 2880
#endif
#ifndef LDXP
#define LDXP 1024
#endif
constexpr int LDX = LDXP;
constexpr int LDA_ACT = LDACT;
constexpr float EPS = 1e-6f;
typedef unsigned u32x4 __attribute__((ext_vector_type(4)));
typedef float f32x2 __attribute__((ext_vector_type(2)));

__device__ __forceinline__ float bf_lo(unsigned w) { return __uint_as_float(w << 16); }
__device__ __forceinline__ float bf_hi(unsigned w) { return __uint_as_float(w & 0xffff0000u); }
__device__ __forceinline__ float sigmoid_f(float x) { return __builtin_amdgcn_rcpf(1.0f + __builtin_amdgcn_exp2f(-1.44269504f * x)); }
__device__ __forceinline__ float dpp_ror1(float v) { return __builtin_bit_cast(float, __builtin_amdgcn_update_dpp(0, __builtin_bit_cast(int, v), 0x121, 0xf, 0xf, true)); }
__device__ __forceinline__ float dpp_ror2(float v) { return __builtin_bit_cast(float, __builtin_amdgcn_update_dpp(0, __builtin_bit_cast(int, v), 0x122, 0xf, 0xf, true)); }

#ifndef USE_FMAC_DPP
#define USE_FMAC_DPP 1
#endif
#ifndef USE_NT
#define USE_NT 0
#endif
#if USE_NT
#define NT_STORE(p, v) __builtin_nontemporal_store((v), (p))
#else
#define NT_STORE(p, v) (*(p) = (v))
#endif
constexpr int RS_OFF = STAGE_BYTES, RS_SLOTS = 8, CWL_OFF = RS_OFF + RS_SLOTS * 1024;
template <class Sched> __device__ __forceinline__ int fill_rs(PG8_LAS unsigned char* lds, const Sched& S, const float* xss) {
    int tid = threadIdx.x; asm volatile("" : "+v"(tid));
    Unit u0, ul; if (!S.next(0, u0)) return 0;
    int n = 0; while (S.next(n, ul)) ++n;
    S.next(n - 1, ul);
    const int pm0 = u0.pm, nslots = ((ul.pm - pm0) >> 3) + 1;
    PG8_LAS float* RS = (PG8_LAS float*)(lds + RS_OFF);
    for (int idx = tid; idx < nslots * 256 && idx < RS_SLOTS * 256; idx += 512) {
        const int row = (pm0 + 8 * (idx >> 8)) * BM + (idx & 255);
        const f32x4* p = (const f32x4*)(xss + (size_t)row * 16);
        const f32x4 a = p[0], b = p[1], c = p[2], d = p[3];
        const float s = ((a[0] + a[1]) + (a[2] + a[3])) + ((b[0] + b[1]) + (b[2] + b[3])) + ((c[0] + c[1]) + (c[2] + c[3])) + ((d[0] + d[1]) + (d[2] + d[3]));
        RS[idx] = rsqrtf(s * (1.0f / DM) + EPS);
    }
    __syncthreads();
    return pm0;
}
__device__ __forceinline__ float row_rstd(const PG8_LAS float* rs, int r) { return rs[r]; }

#ifndef DUP_EPI
#define DUP_EPI 1
#endif
struct EpiIn {
    static constexpr bool PERM = true, AFTER_DRAIN = false; static constexpr int REP = DUP_EPI;
    __device__ __forceinline__ void first_unit(const Unit&, int, PG8_LAS unsigned char*) const {}
    __device__ __forceinline__ void pretouch(const Unit&, int, unsigned (&)[2]) const {}
    const PG8_LAS float* RS; int pm0; bf16_t *CX  , *V; float* vst; size_t ostride; int skip;
    template <bool SIG> __device__ __forceinline__ static void gate_store(f32x4 (&acc)[2][2][4][2], bf16_t* O, const PG8_LAS float* rsb, int row0, int col0) {
#pragma unroll
        for (int ai = 0; ai < 2; ++ai)
#pragma unroll
            for (int m = 0; m < 4; ++m) {
                const int row = row0 + ai * 128 + m * 16; const float r = rsb[ai * 128 + m * 16];
                f32x4 o[2];
#pragma unroll
                for (int n = 0; n < 2; ++n) {
                    const f32x4 a = acc[ai][0][m][n] * r, b = acc[ai][1][m][n] * r;
                    if (!SIG) o[n] = a * b;
                    else { o[n][0] = a[0] * sigmoid_f(b[0]); o[n][1] = a[1] * sigmoid_f(b[1]); o[n][2] = a[2] * sigmoid_f(b[2]); o[n][3] = a[3] * sigmoid_f(b[3]); }
                }
                u32x4 w; w.x = cvt_pk_bf16(o[0][0], o[0][1]); w.y = cvt_pk_bf16(o[0][2], o[0][3]); w.z = cvt_pk_bf16(o[1][0], o[1][1]); w.w = cvt_pk_bf16(o[1][2], o[1][3]);
                NT_STORE((u32x4*)((char*)O + (unsigned)((row * DM + col0) * 2)), w);
            }
    }
    __device__ __forceinline__ void operator()(f32x4 (&acc)[2][2][4][2], const Unit& u, int wr, int wc, int fr_, int fq_, int next_pn, int ui, const unsigned (&tch)[2]) const {
        int fr = fr_, fq = fq_; asm volatile("" : "+v"(fr), "+v"(fq));
        const int row0 = u.pm * BM + wr * 64 + fr;
        if (skip) return;
        const int type = u.pn >> 3;
        const PG8_LAS float* rsb = RS + ((u.pm - pm0) >> 3) * 256 + wr * 64 + fr;
        if (type == 3) {
            const int vt = u.pn - 24, col0 = vt * 256 + wc * 32 + 8 * fq;
#pragma unroll
            for (int ai = 0; ai < 2; ++ai)
#pragma unroll
                for (int m = 0; m < 4; ++m) {
                    const int row = row0 + ai * 128 + m * 16; const float r = rsb[ai * 128 + m * 16]; float s = 0.f, q = 0.f;
#pragma unroll
                    for (int bj = 0; bj < 2; ++bj) {
                        const f32x4 v0 = acc[ai][bj][m][0] * r, v1 = acc[ai][bj][m][1] * r;
                        u32x4 w; w.x = cvt_pk_bf16(v0[0], v0[1]); w.y = cvt_pk_bf16(v0[2], v0[3]); w.z = cvt_pk_bf16(v1[0], v1[1]); w.w = cvt_pk_bf16(v1[2], v1[3]);
                        NT_STORE((u32x4*)((char*)V + (unsigned)((row * DM + col0 + bj * HALF) * 2)), w);
#pragma unroll
                        for (int k = 0; k < 4; ++k) { const float a = bf_lo(w[k]), b = bf_hi(w[k]); s += a + b; q += a * a + b * b; }
                    }
                    s += __shfl_xor(s, 16); s += __shfl_xor(s, 32); q += __shfl_xor(q, 16); q += __shfl_xor(q, 32);
                    if (fq == 0) *(f32x2*)((char*)vst + (unsigned)((row * 16 + vt * 4 + wc) * 8)) = (f32x2){s, q};
                }
        } else {
            bf16_t* O = CX + (size_t)type * ostride;
            const int col0 = (u.pn & 7) * 128 + wc * 32 + 8 * fq;
            if (type == 0) gate_store<false>(acc, O, rsb, row0, col0); else gate_store<true>(acc, O, rsb, row0, col0);
        }
    }
};

struct EpiRes {
    static constexpr bool PERM = true, AFTER_DRAIN = false; static constexpr int REP = 1;
    __device__ __forceinline__ void first_unit(const Unit&, int, PG8_LAS unsigned char*) const {}
    __device__ __forceinline__ void pretouch(const Unit& u, int tid, unsigned (&tch)[2]) const {
        if (noload) return;
        const unsigned off = (unsigned)((u.pm * BM + (tid >> 1)) * (LDX * 2) + u.pn * 512 + (tid & 1) * 256);
        const char* p = (const char*)X + off;
        asm volatile("global_load_dword %0, %2, off\n\tglobal_load_dword %1, %2, off offset:128" : "=&v"(tch[0]), "=&v"(tch[1]) : "v"(p) : "memory");
    }
    bf16_t* X; float* xss; int noload;
    __device__ __forceinline__ void operator()(f32x4 (&acc)[2][2][4][2], const Unit& u, int wr, int wc, int fr_, int fq_, int next_pn, int ui, const unsigned (&tch)[2]) const {
        int fr = fr_, fq = fq_; asm volatile("" : "+v"(fr), "+v"(fq));
        const int row0 = u.pm * BM + wr * 64 + fr, col0 = u.pn * BM + wc * 32 + 8 * fq;
#pragma unroll
        for (int ai = 0; ai < 2; ++ai) {
            u32x4 old[4][2];
#pragma unroll
            for (int m = 0; m < 4; ++m)
#pragma unroll
                for (int bj = 0; bj < 2; ++bj)
                    old[m][bj] = noload ? (u32x4){0u, 0u, 0u, 0u} : *(const u32x4*)((const char*)X + (unsigned)(((row0 + ai * 128 + m * 16) * LDX + col0 + bj * HALF) * 2));
#pragma unroll
            for (int m = 0; m < 4; ++m) {
                const int row = row0 + ai * 128 + m * 16; float q = 0.f;
#pragma unroll
                for (int bj = 0; bj < 2; ++bj) {
                    const u32x4 o4 = old[m][bj]; const f32x4 a0 = acc[ai][bj][m][0], a1 = acc[ai][bj][m][1];
                    u32x4 w;
                    w.x = cvt_pk_bf16(bf_lo(o4.x) + a0[0], bf_hi(o4.x) + a0[1]); w.y = cvt_pk_bf16(bf_lo(o4.y) + a0[2], bf_hi(o4.y) + a0[3]);
                    w.z = cvt_pk_bf16(bf_lo(o4.z) + a1[0], bf_hi(o4.z) + a1[1]); w.w = cvt_pk_bf16(bf_lo(o4.w) + a1[2], bf_hi(o4.w) + a1[3]);
                    *(u32x4*)((char*)X + (unsigned)((row * LDX + col0 + bj * HALF) * 2)) = w;
#pragma unroll
                    for (int k = 0; k < 4; ++k) { const float a = bf_lo(w[k]), b = bf_hi(w[k]); q += a * a + b * b; }
                }
                q += __shfl_xor(q, 16); q += __shfl_xor(q, 32);
                if (fq == 0) *(float*)((char*)xss + (unsigned)((row * 16 + u.pn * 4 + wc) * 4)) = q;
            }
        }
        asm volatile("" :: "v"(tch[0]), "v"(tch[1]));
    }
};

__device__ __forceinline__ f32x4 ror1_4(f32x4 v) { return (f32x4){dpp_ror1(v[0]), dpp_ror1(v[1]), dpp_ror1(v[2]), dpp_ror1(v[3])}; }
__device__ __forceinline__ f32x4 ror2_4(f32x4 v) { return (f32x4){dpp_ror2(v[0]), dpp_ror2(v[1]), dpp_ror2(v[2]), dpp_ror2(v[3])}; }
__device__ __forceinline__ f32x4 sel4(bool c, f32x4 a, f32x4 b) { return (f32x4){c ? a[0] : b[0], c ? a[1] : b[1], c ? a[2] : b[2], c ? a[3] : b[3]}; }
struct EpiUp {
    static constexpr bool PERM = true, AFTER_DRAIN = false; static constexpr int REP = 1;
    __device__ __forceinline__ f32x4 cw_load(int pn, int tid) const { const int t = tid >> 6, c4 = tid & 63; return *(const f32x4*)(cw + t * NUP + (c4 < 32 ? 0 : DFF - 128) + pn * 128 + 4 * c4); }
    __device__ __forceinline__ void first_unit(const Unit& u, int tid, PG8_LAS unsigned char* lds) const {
        if (tid < 192) *(PG8_LAS f32x4*)(lds + CWL_OFF + tid * 16) = cw_load(u.pn, tid);
    }
    __device__ __forceinline__ void pretouch(const Unit&, int, unsigned (&)[2]) const {}
    const PG8_LAS float* RS; int pm0; const float* cw  ; PG8_LAS unsigned char* cwl0; bf16_t* ACT; bf16_t* RAWB  ;
    __device__ __forceinline__ void operator()(f32x4 (&acc)[2][2][4][2], const Unit& u, int wr, int wc, int fr_, int fq_, int next_pn, int ui, const unsigned (&tch)[2]) const {
        int fr = fr_, fq = fq_; asm volatile("" : "+v"(fr), "+v"(fq));
        const int row0 = u.pm * BM + wr * 64 + fr;
        const int tc0 = wc * 32 + 8 * fq;
        int tidq = threadIdx.x; asm volatile("" : "+v"(tidq));
        f32x4 nextw = (f32x4){0.f, 0.f, 0.f, 0.f};
        if (next_pn >= 0 && tidq < 192) nextw = cw_load(next_pn, tidq);
        const PG8_LAS unsigned char* cwl = cwl0 + (ui & 1) * 3072;
        const PG8_LAS float* rsb = RS + ((u.pm - pm0) >> 3) * 256 + wr * 64 + fr;
#pragma unroll
        for (int ai = 0; ai < 2; ++ai)
#pragma unroll
            for (int m = 0; m < 4; ++m) {
                const float r = rsb[ai * 128 + m * 16];
#pragma unroll
                for (int bj = 0; bj < 2; ++bj) { acc[ai][bj][m][0] *= r; acc[ai][bj][m][1] *= r; }
                if (m == 0 || m == 3) {
                    const bool sv = (m == 0) ? (fr < 2) : (fr >= 14);
                    if (sv) {
                        const int grp = (u.pm * BM + ai * 128 + wr * 64) >> 6, slot = (m == 0) ? fr : (fr - 12);
#pragma unroll
                        for (int bj = 0; bj < 2; ++bj) {
                            const f32x4 v0 = acc[ai][bj][m][0], v1 = acc[ai][bj][m][1];
                            u32x4 w; w.x = cvt_pk_bf16(v0[0], v0[1]); w.y = cvt_pk_bf16(v0[2], v0[3]); w.z = cvt_pk_bf16(v1[0], v1[1]); w.w = cvt_pk_bf16(v1[2], v1[3]);
                            *(u32x4*)((char*)RAWB + (unsigned)(((grp * 4 + slot) * NUP + u.pn * 256 + bj * HALF + tc0) * 2)) = w;
                        }
                    }
                }
            }
        const bool f1 = fr >= 1, f2 = fr >= 2;
        const f32x4 zero4 = (f32x4){0.f, 0.f, 0.f, 0.f};
        (void)f1; (void)f2; (void)zero4;
#if USE_FMAC_DPP
        __builtin_amdgcn_sched_barrier(0); asm volatile("s_nop 4" ::: "memory"); __builtin_amdgcn_sched_barrier(0);
#endif
#pragma unroll
        for (int n = 0; n < 2; ++n) {
            f32x4 w[2][3];
#pragma unroll
            for (int bj = 0; bj < 2; ++bj)
#pragma unroll
                for (int t = 0; t < 3; ++t) w[bj][t] = *(const PG8_LAS f32x4*)(cwl + (t * 256 + bj * 128 + tc0 + 4 * n) * 4);
#pragma unroll
            for (int ai = 0; ai < 2; ++ai) {
                f32x4 y[2][4];
#pragma unroll
                for (int bj = 0; bj < 2; ++bj) {
#if USE_FMAC_DPP
#pragma unroll
                    for (int m = 0; m < 4; ++m) {
                        const f32x4 x = acc[ai][bj][m][n]; f32x4 yy = w[bj][2] * x;
                        float y0 = yy[0], y1 = yy[1], y2 = yy[2], y3 = yy[3];
#define FD(Y, X, W, CTRL) asm volatile("v_fmac_f32_dpp %0, %1, %2 " CTRL " row_mask:0xf bank_mask:0xf bound_ctrl:1" : "+v"(Y) : "v"(X), "v"(W))
                        FD(y0, x[0], w[bj][1][0], "row_shr:1"); FD(y1, x[1], w[bj][1][1], "row_shr:1"); FD(y2, x[2], w[bj][1][2], "row_shr:1"); FD(y3, x[3], w[bj][1][3], "row_shr:1");
                        FD(y0, x[0], w[bj][0][0], "row_shr:2"); FD(y1, x[1], w[bj][0][1], "row_shr:2"); FD(y2, x[2], w[bj][0][2], "row_shr:2"); FD(y3, x[3], w[bj][0][3], "row_shr:2");
                        if (m > 0) { const f32x4 xp = acc[ai][bj][m > 0 ? m - 1 : 0][n];
                            FD(y0, xp[0], w[bj][1][0], "row_shl:15"); FD(y1, xp[1], w[bj][1][1], "row_shl:15"); FD(y2, xp[2], w[bj][1][2], "row_shl:15"); FD(y3, xp[3], w[bj][1][3], "row_shl:15");
                            FD(y0, xp[0], w[bj][0][0], "row_shl:14"); FD(y1, xp[1], w[bj][0][1], "row_shl:14"); FD(y2, xp[2], w[bj][0][2], "row_shl:14"); FD(y3, xp[3], w[bj][0][3], "row_shl:14"); }
#undef FD
                        y[bj][m] = (f32x4){y0, y1, y2, y3};
                    }
#else
                    f32x4 a1n = ror1_4(acc[ai][bj][3][n]), a2n = ror2_4(acc[ai][bj][3][n]);
#pragma unroll
                    for (int m = 3; m >= 0; --m) {
                        const f32x4 a1 = a1n, a2 = a2n;
                        if (m > 0) { a1n = ror1_4(acc[ai][bj][m - 1][n]); a2n = ror2_4(acc[ai][bj][m - 1][n]); } else { a1n = zero4; a2n = zero4; }
                        y[bj][m] = w[bj][2] * acc[ai][bj][m][n] + w[bj][1] * sel4(f1, a1, a1n) + w[bj][0] * sel4(f2, a2, a2n);
                    }
#endif
                }
#pragma unroll
                for (int m = 0; m < 4; ++m) {
                    const int row = row0 + ai * 128 + m * 16;
                    const f32x4 g = y[0][m], v = y[1][m];
                    const unsigned lo = cvt_pk_bf16(g[0] * sigmoid_f(g[0]) * v[0], g[1] * sigmoid_f(g[1]) * v[1]), hi = cvt_pk_bf16(g[2] * sigmoid_f(g[2]) * v[2], g[3] * sigmoid_f(g[3]) * v[3]);
                    NT_STORE((unsigned long long*)((char*)ACT + (unsigned)((row * LDA_ACT + u.pn * 128 + tc0 + 4 * n) * 2)), (unsigned long long)lo | ((unsigned long long)hi << 32));
                }
            }
        }
        if (next_pn >= 0 && tidq < 192) *(PG8_LAS f32x4*)(cwl0 + ((ui + 1) & 1) * 3072 + tidq * 16) = nextw;
    }
};
template <class Epi, class Sched, bool STAMP = false>
__device__ __forceinline__ void gemm_phase(PG8_LAS unsigned char* lds, const Gemm g, const Sched& S, const Epi& E, unsigned long long* stamps) {
    int tid_ = threadIdx.x; asm volatile("" : "+v"(tid_));
    const int tid = tid_, wid = __builtin_amdgcn_readfirstlane(tid >> 6), lane = tid & 63, wr = wid >> 2, wc = wid & 3, fr = lane & 15, fq = lane >> 4;
    const int K = g.K, nt = K / BK;
    int ts_lo = 0, ts_hi = 0, nts = 0; const unsigned long long rt_entry = STAMP ? (unsigned long long)wall_clock64() : 0ull;
#define PG8_STAMP() do { if (STAMP && wid == 0 && nts < 64) { const unsigned long long _c = (unsigned long long)clock64(); \
        ts_lo = (lane == nts) ? (int)(unsigned)_c : ts_lo; ts_hi = (lane == nts) ? (int)(unsigned)(_c >> 32) : ts_hi; ++nts; } } while (0)
    PG8_STAMP();
    unsigned voffA[2], voffB[2];
#pragma unroll
    for (int i = 0; i < 2; ++i) { int R, C; stage_rc(tid * 16 + i * 8192, R, C); const int Rb = Epi::PERM ? ((R & ~31) + perm32(R & 31)) : R;
        voffA[i] = (unsigned)(R * g.lda + C) * 2u; voffB[i] = (unsigned)(Rb * K + C) * 2u; }
    const size_t kstep = (size_t)(BK * 2);
    const size_t hstep = (size_t)HALF * K * 2;
    const size_t tstep = 2 * hstep;
    const size_t hstepA = (size_t)HALF * g.lda * 2, tstepA = 2 * hstepA;
    const unsigned ldsw = (unsigned)wid * 1024u;
    const int aoff = lds_byte(wr * 64 + fr, fq * 8), boff = lds_byte(wc * 32 + fr, fq * 8);
#define PG8_SA(b, h) (((b) * 2 + (h)) * HTB)
#define PG8_SB(b, h) ((4 + (b) * 2 + (h)) * HTB)
#define PG8_STAGE(bufoff, gbase, voff) do { _Pragma("unroll") for (int _i = 0; _i < 2; ++_i) \
        __builtin_amdgcn_global_load_lds((const unsigned*)((const char*)(gbase) + (voff)[_i]), (PG8_LAS unsigned*)(lds + (bufoff) + ldsw + _i * 8192), 16, 0, 0); } while (0)
#define PG8_LDA(dst, b, h) do { _Pragma("unroll") for (int m = 0; m < 4; ++m) _Pragma("unroll") for (int k = 0; k < 2; ++k) dst[m][k] = *(const PG8_LAS bf16x8*)(lds + PG8_SA(b, h) + aoff + m * 2048 + k * 1024); } while (0)
#define PG8_LDB(dst, b, h) do { _Pragma("unroll") for (int n = 0; n < 2; ++n) _Pragma("unroll") for (int k = 0; k < 2; ++k) dst[n][k] = *(const PG8_LAS bf16x8*)(lds + PG8_SB(b, h) + boff + n * 2048 + k * 1024); } while (0)
#define PG8_MMA(ai, bj, At, Bt) do { __builtin_amdgcn_s_setprio(1); _Pragma("unroll") for (int m = 0; m < 4; ++m) _Pragma("unroll") for (int n = 0; n < 2; ++n) _Pragma("unroll") for (int k = 0; k < 2; ++k) \
        acc[ai][bj][m][n] = __builtin_amdgcn_mfma_f32_16x16x32_bf16(Bt[n][k], At[m][k], acc[ai][bj][m][n], 0, 0, 0); __builtin_amdgcn_s_setprio(0); } while (0)
#define PG8_WAIT_V(n) asm volatile("s_waitcnt vmcnt(" #n ")" ::: "memory")
#define PG8_WAIT_L(n) asm volatile("s_waitcnt lgkmcnt(" #n ")" ::: "memory")
#define PG8_BAR __builtin_amdgcn_s_barrier()
#define PG8_SCHED __builtin_amdgcn_sched_barrier(0)
    Unit cur, nxt; int ui = 0; unsigned tch[2] = {0u, 0u};
    if (!S.next(0, cur)) return;
    f32x4 acc[2][2][4][2];
#pragma unroll
    for (int a = 0; a < 2; ++a)
#pragma unroll
        for (int b = 0; b < 2; ++b)
#pragma unroll
            for (int m = 0; m < 4; ++m)
#pragma unroll
                for (int n = 0; n < 2; ++n) acc[a][b][m][n] = (f32x4){0.f, 0.f, 0.f, 0.f};
    bf16x8 At[4][2], B0[2][2], B1[2][2];
    const char* cA = (const char*)g.A + (size_t)cur.pm * tstepA; const char* cB = (const char*)g.Bt + (size_t)cur.pn * tstep;
    S.a_ready(cur);
    E.first_unit(cur, tid, lds);
    PG8_STAGE(PG8_SB(0, 0), cB, voffB); PG8_STAGE(PG8_SA(0, 0), cA, voffA); PG8_STAGE(PG8_SB(0, 1), cB + hstep, voffB); PG8_STAGE(PG8_SA(0, 1), cA + hstepA, voffA);
    if (wr == 1) PG8_BAR;
    PG8_WAIT_V(4); PG8_BAR;
    PG8_STAGE(PG8_SB(1, 0), cB + kstep, voffB); PG8_STAGE(PG8_SA(1, 0), cA + kstep, voffA); PG8_STAGE(PG8_SB(1, 1), cB + hstep + kstep, voffB);
    PG8_WAIT_V(6); PG8_BAR;
    PG8_STAMP();
    for (;;) {
        const bool has_next = S.next(ui + 1, nxt);
        const char* nA = has_next ? (const char*)g.A + (size_t)nxt.pm * tstepA : cA; const char* nB = has_next ? (const char*)g.Bt + (size_t)nxt.pn * tstep : cB;
        for (int t = 0; t < nt; t += 2) {
            const bool last = (t == nt - 2);
            const char* a1 = cA + (size_t)(t + 1) * kstep;
            const char* a2 = last ? nA : cA + (size_t)(t + 2) * kstep; const char* b2 = last ? nB : cB + (size_t)(t + 2) * kstep;
            const char* a3 = a2 + kstep; const char* b3 = b2 + kstep;
            if (last && has_next) S.a_ready(nxt);
            if (last) E.pretouch(cur, tid, tch);
            PG8_LDB(B0, 0, 0); PG8_SCHED; PG8_LDA(At, 0, 0); PG8_STAGE(PG8_SA(1, 1), a1 + hstepA, voffA);
            PG8_WAIT_L(8); PG8_BAR; PG8_WAIT_L(0); PG8_MMA(0, 0, At, B0); PG8_BAR; PG8_SCHED;
            PG8_LDB(B1, 0, 1); PG8_STAGE(PG8_SB(0, 0), b2, voffB);
            PG8_BAR; PG8_WAIT_L(0); PG8_MMA(0, 1, At, B1); PG8_BAR;
            PG8_LDA(At, 0, 1); PG8_STAGE(PG8_SA(0, 0), a2, voffA);
            PG8_BAR; PG8_WAIT_L(0); PG8_MMA(1, 0, At, B0); PG8_BAR; PG8_SCHED;
            PG8_STAGE(PG8_SB(0, 1), b2 + hstep, voffB);
            PG8_WAIT_V(6); PG8_BAR; PG8_MMA(1, 1, At, B1); PG8_BAR;
            PG8_LDB(B0, 1, 0); PG8_SCHED; PG8_LDA(At, 1, 0); PG8_STAGE(PG8_SA(0, 1), a2 + hstepA, voffA);
            PG8_WAIT_L(8); PG8_BAR; PG8_WAIT_L(0); PG8_MMA(0, 0, At, B0); PG8_BAR; PG8_SCHED;
            PG8_LDB(B1, 1, 1); PG8_STAGE(PG8_SB(1, 0), b3, voffB);
            PG8_BAR; PG8_WAIT_L(0); PG8_MMA(0, 1, At, B1); PG8_BAR;
            PG8_LDA(At, 1, 1); PG8_STAGE(PG8_SA(1, 0), a3, voffA);
            PG8_BAR; PG8_WAIT_L(0); PG8_MMA(1, 0, At, B0); PG8_BAR; PG8_SCHED;
            PG8_STAGE(PG8_SB(1, 1), b3 + hstep, voffB);
            PG8_WAIT_V(6); PG8_BAR; PG8_MMA(1, 1, At, B1); PG8_BAR;
        }
        PG8_STAMP();
        if constexpr (!Epi::AFTER_DRAIN) { for (int rep_ = 0; rep_ < Epi::REP; ++rep_) E(acc, cur, wr, wc, fr, fq, has_next ? nxt.pn : -1, ui, tch); S.done(cur); }
        PG8_STAMP();
        if (!has_next) break;
#pragma unroll
        for (int a = 0; a < 2; ++a)
#pragma unroll
            for (int b = 0; b < 2; ++b)
#pragma unroll
                for (int m = 0; m < 4; ++m)
#pragma unroll
                    for (int n = 0; n < 2; ++n) acc[a][b][m][n] = (f32x4){0.f, 0.f, 0.f, 0.f};
        cur = nxt; cA = nA; cB = nB; ++ui;
    }
    PG8_WAIT_V(0);
    if (wr == 0) PG8_BAR;
    PG8_BAR;
    if constexpr (Epi::AFTER_DRAIN) { E.fused(acc, cur, wr, wc, fr, fq, lds, wid, lane); S.done(cur); }
    PG8_STAMP();
    if (STAMP && wid == 0) { stamps[lane] = lane < nts ? (((unsigned long long)(unsigned)ts_hi << 32) | (unsigned)ts_lo) : 0ull;
        if (lane == 62) stamps[62] = rt_entry; if (lane == 63) stamps[63] = (unsigned long long)wall_clock64(); }
#undef PG8_STAMP
#undef PG8_SA
#undef PG8_SB
#undef PG8_STAGE
#undef PG8_LDA
#undef PG8_LDB
#undef PG8_MMA
#undef PG8_WAIT_V
#undef PG8_WAIT_L
#undef PG8_BAR
#undef PG8_SCHED
}
}
using pg8::bf16_t; using pg8::f32x4; using pg8::bf16x8; using pg8::u32x4; using pg8::f32x2;
using pg8::LDA_ACT; using pg8::LDX; using pg8::MTOK; using pg8::DM; using pg8::SEQ; using pg8::NIN; using pg8::DFF; using pg8::NUP; using pg8::DEPTH; using pg8::EPS;
#define LAS __attribute__((address_space(3)))

constexpr size_t MiB = 1u << 20;
constexpr size_t WS_WIN = 0;
constexpr size_t WS_WOUT = 28 * MiB;
constexpr size_t WS_WUP = 32 * MiB;
constexpr size_t WS_WDN = 54 * MiB;
constexpr size_t WS_XSS = 66 * MiB;
constexpr size_t WS_VST = 70 * MiB;
constexpr size_t WS_X = 78 * MiB;
constexpr size_t WS_ARENA = 256 * MiB, ARENA = 80 * MiB, AR_CX = 0, AR_BSG = 16 * MiB, AR_UG = 32 * MiB, AR_V = 48 * MiB, AR_MRG = 64 * MiB, AR_ACT = 0, AR_RAWB = 48 * MiB;
constexpr size_t GROUP_ROWS = 8192;
constexpr size_t WS_END = 896 * MiB;
constexpr size_t WS_CTL = 224 * MiB, CTL_BYTES = 8 * 256;
constexpr int LDS_BYTES = 131072 + 8192 + 6144;
#ifndef USE_COLOC
#define USE_COLOC 1
#endif
#ifndef STAG_TICKS
#define STAG_TICKS 375
#endif

#ifndef DUP_P0
#define DUP_P0 1
#endif
#ifndef DUP_GIN
#define DUP_GIN 1
#endif
#ifndef DUP_SGU
#define DUP_SGU 1
#endif
#ifndef DUP_GUP
#define DUP_GUP 1
#endif
#ifndef DUP_FIX
#define DUP_FIX 1
#endif
#ifndef DUP_FIN
#define DUP_FIN 1
#endif
#ifndef DUP_GOUT
#define DUP_GOUT 1
#endif
#ifndef DUP_GDN
#define DUP_GDN 1
#endif
#ifndef PROBE_SKIPEPI
#define PROBE_SKIPEPI 0
#endif
#ifndef PROBE_NOLOAD
#define PROBE_NOLOAD 0
#endif
#ifndef DUP_SYNC
#define DUP_SYNC 1
#endif
static_assert(DUP_GOUT == 1 && DUP_GDN == 1, "the scratch-copy probes of Gout / Gdown have no room in this workspace map");
struct Params {
    const float *x, *mix_g, *w_in, *conv_a, *ln_g, *ln_b, *w_s, *b_s, *w_out, *ffn_g, *w_up, *conv_f, *w_dn, *fin_g;
    float* out; unsigned char* ws;
};

__device__ __forceinline__ unsigned f2bf(float f) { unsigned u = __float_as_uint(f); return (u + 0x7fffu + ((u >> 16) & 1u)) >> 16; }
__device__ __forceinline__ unsigned pk2(float lo, float hi) { return pg8::cvt_pk_bf16(lo, hi); }
__device__ __forceinline__ float wave_sum(float v) {
#pragma unroll
    for (int o = 1; o < 64; o <<= 1) v += __shfl_xor(v, o);
    return v;
}

__device__ __forceinline__ void p0_item(const float* W, int N, int K, const float* gk, bf16_t* WT, int k0, int srccol, int dstrow, LAS float* scr, int lane) {
    float v[32];
#pragma unroll
    for (int i = 0; i < 32; ++i) v[i] = W[(size_t)(k0 + 2 * i + (lane >> 5)) * N + srccol + (lane & 31)];
    const int c = lane & 7;
    f32x4 g0 = (f32x4){1.f, 1.f, 1.f, 1.f}, g1 = g0;
    if (gk) { g0 = *(const f32x4*)(gk + k0 + 8 * c); g1 = *(const f32x4*)(gk + k0 + 8 * c + 4); }
#pragma unroll
    for (int i = 0; i < 32; ++i) scr[(2 * i + (lane >> 5)) * 33 + (lane & 31)] = v[i];
    asm volatile("s_waitcnt lgkmcnt(0)" ::: "memory");
#pragma unroll
    for (int j = 0; j < 4; ++j) { const int n = (lane >> 3) + 8 * j; const LAS float* s = scr + (8 * c) * 33 + n;
        u32x4 o; o.x = pk2(s[0 * 33] * g0[0], s[1 * 33] * g0[1]); o.y = pk2(s[2 * 33] * g0[2], s[3 * 33] * g0[3]); o.z = pk2(s[4 * 33] * g1[0], s[5 * 33] * g1[1]); o.w = pk2(s[6 * 33] * g1[2], s[7 * 33] * g1[3]);
        *(u32x4*)(WT + (size_t)(dstrow + n) * K + k0 + 8 * c) = o; }
    asm volatile("s_waitcnt lgkmcnt(0)" ::: "memory");
}
__device__ __forceinline__ int in_srccol(int np) {
    const int pn = np >> 8, r = np & 255, type = pn >> 3, cb = pn & 7, h = r >> 7, i = r & 127;
    if (type == 0) return (h ? 2048 : 1024) + 128 * cb + i;
    if (type == 1) return (h ? 5120 : 0) + 128 * cb + i;
    if (type == 2) return (h ? 6144 : 3072) + 128 * cb + i;
    return 4096 + 256 * (pn - 24) + r;
}
__device__ __forceinline__ int up_srccol(int np) { const int pn = np >> 8, r = np & 255; return ((r >> 7) ? DFF : 0) + 128 * pn + (r & 127); }

__device__ __forceinline__ void p0_phase(const Params& P, LAS unsigned char* lds) {
    int tid_ = threadIdx.x; asm volatile("" : "+v"(tid_));
    const int tid = tid_, lane = tid & 63, wave = tid >> 6;
    LAS float* scr = (LAS float*)(lds + wave * 16384);
    const int gw = blockIdx.x * 8 + wave, NGW = gridDim.x * 8;
    constexpr int I_IN = 16 * (NIN / 32), I_OUT = 16 * (DM / 32), I_UP = 16 * (NUP / 32), I_DN = (DFF / 64) * (DM / 32);
    constexpr int PER_L = I_IN + I_OUT + I_UP + I_DN;
    bf16_t* WIN = (bf16_t*)(P.ws + WS_WIN); bf16_t* WOUT = (bf16_t*)(P.ws + WS_WOUT); bf16_t* WUP = (bf16_t*)(P.ws + WS_WUP); bf16_t* WDN = (bf16_t*)(P.ws + WS_WDN);
    for (int it = gw; it < DEPTH * PER_L; it += NGW) {
        const int l = it / PER_L; int r = it % PER_L;
        if (r < I_IN) { const int kb = r / (NIN / 32), nb = r % (NIN / 32); p0_item(P.w_in + (size_t)l * DM * NIN, NIN, DM, P.mix_g + l * DM, WIN + (size_t)l * NIN * DM, 64 * kb, in_srccol(32 * nb), 32 * nb, scr, lane); continue; } r -= I_IN;
        if (r < I_OUT) { const int kb = r / (DM / 32), nb = r % (DM / 32); p0_item(P.w_out + (size_t)l * DM * DM, DM, DM, nullptr, WOUT + (size_t)l * DM * DM, 64 * kb, 32 * nb, 32 * nb, scr, lane); continue; } r -= I_OUT;
        if (r < I_UP) { const int kb = r / (NUP / 32), nb = r % (NUP / 32); p0_item(P.w_up + (size_t)l * DM * NUP, NUP, DM, P.ffn_g + l * DM, WUP + (size_t)l * NUP * DM, 64 * kb, up_srccol(32 * nb), 32 * nb, scr, lane); continue; } r -= I_UP;
        { const int kb = r / (DM / 32), nb = r % (DM / 32); p0_item(P.w_dn + (size_t)l * DFF * DM, DM, DFF, nullptr, WDN + (size_t)l * DM * DFF, 64 * kb, 32 * nb, 32 * nb, scr, lane); }
    }
    bf16_t* X = (bf16_t*)(P.ws + WS_X); float* xss = (float*)(P.ws + WS_XSS);
    for (int m0 = gw * 4; m0 < MTOK; m0 += NGW * 4) {
        f32x4 v[4][4];
#pragma unroll
        for (int r = 0; r < 4; ++r)
#pragma unroll
            for (int j = 0; j < 4; ++j) v[r][j] = ((const f32x4*)(P.x + (size_t)(m0 + r) * DM) + lane)[64 * j];
        float s[4];
#pragma unroll
        for (int r = 0; r < 4; ++r) {
            unsigned long long* o8 = (unsigned long long*)(X + (size_t)(m0 + r) * LDX) + lane; s[r] = 0.f;
#pragma unroll
            for (int j = 0; j < 4; ++j) { const unsigned a = pk2(v[r][j][0], v[r][j][1]), b = pk2(v[r][j][2], v[r][j][3]);
                o8[64 * j] = (unsigned long long)a | ((unsigned long long)b << 32);
                const float f0 = pg8::bf_lo(a), f1 = pg8::bf_hi(a), f2 = pg8::bf_lo(b), f3 = pg8::bf_hi(b); s[r] += (f0 * f0 + f1 * f1) + (f2 * f2 + f3 * f3); }
        }
#pragma unroll
        for (int r = 0; r < 4; ++r) { const float t = wave_sum(s[r]); if (lane < 16) xss[(size_t)(m0 + r) * 16 + lane] = lane == 0 ? t : 0.f; }
    }
}

__device__ __forceinline__ int vt_key(int rho) { return ((rho >> 2) & 3) | (((rho >> 5) & 3) << 2); }
struct GroupBufs { bf16_t *CX, *BSG, *UG, *V, *MRG, *ACT, *RAWB; };
__device__ __forceinline__ void sgu_phase(const Params& P, const GroupBufs& B, LAS unsigned char* lds, int l) {
    int tid_ = threadIdx.x; asm volatile("" : "+v"(tid_));
    const int tid = tid_, lane = tid & 63, w = __builtin_amdgcn_readfirstlane(tid >> 6), fr = lane & 15, fq = lane >> 4;
    const int xg = blockIdx.x & 7, jb = blockIdx.x >> 3, g = jb & 7;
    LAS unsigned* WS = (LAS unsigned*)lds;
    LAS unsigned* VT = (LAS unsigned*)(lds + 32768);
    LAS f32x2* ST = (LAS f32x2*)(lds + 65536);
    LAS float* CW = (LAS float*)(lds + 65536 + 1024);
    const bf16_t* V = B.V; const bf16_t* UG = B.UG; const bf16_t* BSG = B.BSG; const bf16_t* CX = B.CX;
    bf16_t* MRG = B.MRG; const float* vst = (const float*)(P.ws + WS_VST);
    __syncthreads();
    {
        const float* Wg = P.w_s + ((size_t)l * 8 + g) * 128 * 128;
#pragma unroll
        for (int i = 0; i < 4; ++i) { const int idx = tid + 512 * i, t = idx >> 4, s8 = idx & 15;
            const f32x4 a = *(const f32x4*)(Wg + t * 128 + 8 * s8), b = *(const f32x4*)(Wg + t * 128 + 8 * s8 + 4);
            float v[8] = {a[0], a[1], a[2], a[3], b[0], b[1], b[2], b[3]};
#pragma unroll
            for (int j = 0; j < 8; ++j) if (8 * s8 + j > t) v[j] = 0.f;
            u32x4 o; o.x = pk2(v[0], v[1]); o.y = pk2(v[2], v[3]); o.z = pk2(v[4], v[5]); o.w = pk2(v[6], v[7]);
            *(LAS u32x4*)(WS + t * 64 + ((4 * s8) ^ ((t & 15) << 2))) = o; }
        if (tid < 384) CW[tid] = P.conv_a[(size_t)l * 3 * DM + (tid >> 7) * DM + 128 * g + (tid & 127)];
    }
    const int c8 = tid & 15;
    float lg[8], lb[8];
#pragma unroll
    for (int j = 0; j < 8; ++j) { lg[j] = P.ln_g[l * DM + 128 * g + 8 * c8 + j]; lb[j] = P.ln_b[l * DM + 128 * g + 8 * c8 + j]; }
    const float bias = P.b_s[((size_t)l * 8 + g) * 128 + 16 * w + fr];
    const int t = 16 * w + fr;
    const int ck0 = 64 * xg + 60 + (jb >> 3), ck_end = 64 * xg;
    u32x4 vreg[2][2]; f32x4 sreg[2];
#define SGU_LOAD_V(ck_) do { const int r0_ = (ck_) * 128; _Pragma("unroll") for (int it = 0; it < 2; ++it) { const int sp = (tid >> 4) + 32 * it; \
        vreg[it][0] = *(const u32x4*)(V + (size_t)(r0_ + 2 * sp) * DM + 128 * g + 8 * c8); vreg[it][1] = *(const u32x4*)(V + (size_t)(r0_ + 2 * sp + 1) * DM + 128 * g + 8 * c8); } \
        const f32x4* sp_ = (const f32x4*)(vst + (size_t)(r0_ + (tid >> 2)) * 32 + 8 * (tid & 3)); sreg[0] = sp_[0]; sreg[1] = sp_[1]; } while (0)
    SGU_LOAD_V(ck0);
    for (int ck = ck0; ck >= ck_end; ck -= 4) {
        const int row0 = ck * 128; const size_t row = (size_t)row0 + t; const bool seq0 = (row0 % SEQ) == 0;
        u32x4 eug[4], ebs[4], ec0[4], ec1[4], ec2[4];
#pragma unroll
        for (int q = 0; q < 4; ++q) { const size_t off = row * DM + 128 * g + 32 * q + 8 * fq;
            eug[q] = *(const u32x4*)(UG + off); ebs[q] = *(const u32x4*)(BSG + off); ec0[q] = *(const u32x4*)(CX + off);
            ec1[q] = (u32x4){0u, 0u, 0u, 0u}; ec2[q] = (u32x4){0u, 0u, 0u, 0u};
            if (!(seq0 && t < 1)) ec1[q] = *(const u32x4*)(CX + off - DM);
            if (!(seq0 && t < 2)) ec2[q] = *(const u32x4*)(CX + off - 2 * DM); }
        { float s = (sreg[0][0] + sreg[0][2]) + (sreg[1][0] + sreg[1][2]), q = (sreg[0][1] + sreg[0][3]) + (sreg[1][1] + sreg[1][3]);
          s += __shfl_xor(s, 1); q += __shfl_xor(q, 1); s += __shfl_xor(s, 2); q += __shfl_xor(q, 2);
          const float mu = s * (1.0f / DM), var = q * (1.0f / DM) - mu * mu;
          if ((tid & 3) == 0) ST[tid >> 2] = (f32x2){mu, rsqrtf(fmaxf(var, 0.f) + EPS)}; }
        __syncthreads();
#pragma unroll
        for (int it = 0; it < 2; ++it) {
            const int sp = (tid >> 4) + 32 * it;
            const u32x4 v0 = vreg[it][0], v1 = vreg[it][1];
            const f32x2 s0 = ST[2 * sp], s1 = ST[2 * sp + 1];
#pragma unroll
            for (int j = 0; j < 8; ++j) {
                const unsigned w0 = v0[j >> 1], w1 = v1[j >> 1];
                const float a = (j & 1) ? pg8::bf_hi(w0) : pg8::bf_lo(w0), b = (j & 1) ? pg8::bf_hi(w1) : pg8::bf_lo(w1);
                const float na = (a - s0[0]) * s0[1] * lg[j] + lb[j], nb = (b - s1[0]) * s1[1] * lg[j] + lb[j];
                const int rho = 32 * (c8 >> 2) + 16 * (j >> 2) + 4 * (c8 & 3) + (j & 3);
                VT[rho * 64 + (sp ^ (vt_key(rho) << 2))] = pk2(na, nb);
            }
        }
        if (ck - 4 >= ck_end) SGU_LOAD_V(ck - 4);
        __syncthreads();
        f32x4 acc[8];
#pragma unroll
        for (int nb = 0; nb < 8; ++nb) acc[nb] = (f32x4){0.f, 0.f, 0.f, 0.f};
        for (int kk = 0; kk <= (w >> 1); ++kk) {
            const bf16x8 wf = *(const LAS bf16x8*)(WS + (16 * w + fr) * 64 + ((16 * kk + 4 * fq) ^ (fr << 2)));
#pragma unroll
            for (int nb = 0; nb < 8; ++nb) { const int rho = 16 * nb + fr;
                const bf16x8 vf = *(const LAS bf16x8*)(VT + rho * 64 + ((16 * kk + 4 * fq) ^ (vt_key(rho) << 2)));
                acc[nb] = __builtin_amdgcn_mfma_f32_16x16x32_bf16(vf, wf, acc[nb], 0, 0, 0); }
        }
#pragma unroll
        for (int q = 0; q < 4; ++q) {
            const int ch = 32 * q + 8 * fq; const size_t off = row * DM + 128 * g + ch;
            const u32x4 ug = eug[q], bs = ebs[q], c0 = ec0[q], c1 = ec1[q], c2 = ec2[q];
            u32x4 o;
#pragma unroll
            for (int k = 0; k < 4; ++k) {
                const int j0 = 2 * k, j1 = 2 * k + 1;
                const float m0 = acc[2 * q + (j0 >> 2)][j0 & 3] + bias, m1 = acc[2 * q + (j1 >> 2)][j1 & 3] + bias;
                const float ya0 = CW[256 + ch + j0] * pg8::bf_lo(c0[k]) + CW[128 + ch + j0] * pg8::bf_lo(c1[k]) + CW[ch + j0] * pg8::bf_lo(c2[k]);
                const float ya1 = CW[256 + ch + j1] * pg8::bf_hi(c0[k]) + CW[128 + ch + j1] * pg8::bf_hi(c1[k]) + CW[ch + j1] * pg8::bf_hi(c2[k]);
                o[k] = pk2(pg8::bf_lo(ug[k]) * m0 + pg8::bf_lo(bs[k]) * ya0, pg8::bf_hi(ug[k]) * m1 + pg8::bf_hi(bs[k]) * ya1);
            }
            *(u32x4*)(MRG + off) = o;
        }
    }
#undef SGU_LOAD_V
    __syncthreads();
}

__device__ __forceinline__ void fix_phase(const Params& P, const GroupBufs& B, int l) {
    const bf16_t* RAWB = B.RAWB; bf16_t* ACT = B.ACT; const float* cw = P.conv_f + (size_t)l * 3 * NUP;
    constexpr int C8 = DFF / 8, NIT = (MTOK / 64 / 8) * 2 * C8;
    int tid_ = threadIdx.x; asm volatile("" : "+v"(tid_));
    const int xg = blockIdx.x & 7, jb = blockIdx.x >> 3;
    for (int it0 = jb * 512 + tid_; it0 < NIT; it0 += 32 * 512) {
        const int it = xg * NIT + it0;
        const int c8 = it % C8, rr = (it / C8) & 1, grp = it / (2 * C8);
        const int ch = 8 * c8, pn = ch >> 7, i = ch & 127, gcol = 256 * pn + i;
        const bool start = ((grp * 64) % SEQ) == 0;
        float o[8];
        float yv[2][8];
#pragma unroll
        for (int h = 0; h < 2; ++h) {
            const int col = gcol + 128 * h; const int wc0 = h * DFF + ch;
            const u32x4 z = (u32x4){0u, 0u, 0u, 0u};
            const u32x4 x0 = *(const u32x4*)(RAWB + ((size_t)grp * 4 + rr) * NUP + col);
            u32x4 x1, x2;
            if (rr == 1) { x1 = *(const u32x4*)(RAWB + ((size_t)grp * 4 + 0) * NUP + col); x2 = start ? z : *(const u32x4*)(RAWB + ((size_t)(grp - 1) * 4 + 3) * NUP + col); }
            else { x1 = start ? z : *(const u32x4*)(RAWB + ((size_t)(grp - 1) * 4 + 3) * NUP + col); x2 = start ? z : *(const u32x4*)(RAWB + ((size_t)(grp - 1) * 4 + 2) * NUP + col); }
            f32x4 wt[3][2];
#pragma unroll
            for (int tp = 0; tp < 3; ++tp) { wt[tp][0] = *(const f32x4*)(cw + tp * NUP + wc0); wt[tp][1] = *(const f32x4*)(cw + tp * NUP + wc0 + 4); }
#pragma unroll
            for (int k = 0; k < 4; ++k) {
                const int ja = 2 * k, jb2 = 2 * k + 1;
                yv[h][ja] = wt[2][ja >> 2][ja & 3] * pg8::bf_lo(x0[k]) + wt[1][ja >> 2][ja & 3] * pg8::bf_lo(x1[k]) + wt[0][ja >> 2][ja & 3] * pg8::bf_lo(x2[k]);
                yv[h][jb2] = wt[2][jb2 >> 2][jb2 & 3] * pg8::bf_hi(x0[k]) + wt[1][jb2 >> 2][jb2 & 3] * pg8::bf_hi(x1[k]) + wt[0][jb2 >> 2][jb2 & 3] * pg8::bf_hi(x2[k]);
            }
        }
#pragma unroll
        for (int j = 0; j < 8; ++j) o[j] = yv[0][j] * pg8::sigmoid_f(yv[0][j]) * yv[1][j];
        u32x4 w; w.x = pk2(o[0], o[1]); w.y = pk2(o[2], o[3]); w.z = pk2(o[4], o[5]); w.w = pk2(o[6], o[7]);
        *(u32x4*)(ACT + ((size_t)grp * 64 + rr) * LDA_ACT + ch) = w;
    }
}

__device__ __forceinline__ void final_phase(const Params& P) {
    int tid_ = threadIdx.x; asm volatile("" : "+v"(tid_));
    const int lane = tid_ & 63, gw = (blockIdx.x >> 3) * 8 + (tid_ >> 6), NGW = 32 * 8, mbase = (blockIdx.x & 7) * (MTOK / 8);
    const bf16_t* X = (const bf16_t*)(P.ws + WS_X); const float* xss = (const float*)(P.ws + WS_XSS);
    const f32x4 g00 = *(const f32x4*)(P.fin_g + 8 * lane), g01 = *(const f32x4*)(P.fin_g + 8 * lane + 4), g10 = *(const f32x4*)(P.fin_g + 8 * lane + 512), g11 = *(const f32x4*)(P.fin_g + 8 * lane + 516);
    for (int m0 = mbase + gw * 4; m0 < mbase + MTOK / 8; m0 += NGW * 4) {
        u32x4 xv[4][2]; float s[4];
#pragma unroll
        for (int r = 0; r < 4; ++r) { s[r] = lane < 16 ? xss[(size_t)(m0 + r) * 16 + lane] : 0.f;
            xv[r][0] = *(const u32x4*)(X + (size_t)(m0 + r) * LDX + 8 * lane); xv[r][1] = *(const u32x4*)(X + (size_t)(m0 + r) * LDX + 8 * lane + 512); }
#pragma unroll
        for (int r = 0; r < 4; ++r) {
            const float rr = rsqrtf(wave_sum(s[r]) * (1.0f / DM) + EPS);
#pragma unroll
            for (int j = 0; j < 2; ++j) {
                const u32x4 x4 = xv[r][j]; const f32x4 ga = j ? g10 : g00, gb = j ? g11 : g01;
                f32x4 o0, o1;
                o0[0] = pg8::bf_lo(x4.x) * rr * ga[0]; o0[1] = pg8::bf_hi(x4.x) * rr * ga[1]; o0[2] = pg8::bf_lo(x4.y) * rr * ga[2]; o0[3] = pg8::bf_hi(x4.y) * rr * ga[3];
                o1[0] = pg8::bf_lo(x4.z) * rr * gb[0]; o1[1] = pg8::bf_hi(x4.z) * rr * gb[1]; o1[2] = pg8::bf_lo(x4.w) * rr * gb[2]; o1[3] = pg8::bf_hi(x4.w) * rr * gb[3];
                float* op = P.out + (size_t)(m0 + r) * DM + 8 * lane + 512 * j;
                *(f32x4*)op = o0; *(f32x4*)(op + 4) = o1;
            }
        }
    }
}

__device__ __forceinline__ void group_sync(unsigned* ctr, unsigned target, int colocated) {
    asm volatile("s_waitcnt vmcnt(0)" ::: "memory");
    __syncthreads();
    if (threadIdx.x == 0) {
        if (!colocated) { __builtin_amdgcn_fence(__ATOMIC_RELEASE, "agent"); asm volatile("s_waitcnt vmcnt(0)" ::: "memory"); }
        __hip_atomic_fetch_add(ctr, 1u, __ATOMIC_RELAXED, __HIP_MEMORY_SCOPE_AGENT);
        while (__hip_atomic_load(ctr, __ATOMIC_RELAXED, __HIP_MEMORY_SCOPE_AGENT) < target) __builtin_amdgcn_s_sleep(1);
        if (!colocated) __builtin_amdgcn_fence(__ATOMIC_ACQUIRE, "agent");
        else asm volatile("buffer_inv sc1" ::: "memory");
        asm volatile("s_waitcnt vmcnt(0)" ::: "memory");
    }
    __syncthreads();
}

__global__ void __launch_bounds__(512, 2) fwd_megakernel(Params P) {
    extern __shared__ __attribute__((aligned(16))) unsigned char lds_raw[];
    LAS unsigned char* lds = (LAS unsigned char*)lds_raw;
    cg::grid_group grid = cg::this_grid();
    const int G = gridDim.x;
    bf16_t* X = (bf16_t*)(P.ws + WS_X); float* xss = (float*)(P.ws + WS_XSS);
    GroupBufs B;
    {   const size_t gx = blockIdx.x & 7; unsigned char* ar = P.ws + WS_ARENA + gx * ARENA;
        const size_t b1k = gx * GROUP_ROWS * DM * 2, bff = gx * GROUP_ROWS * LDA_ACT * 2;
        B.CX = (bf16_t*)(ar + AR_CX - b1k); B.BSG = (bf16_t*)(ar + AR_BSG - b1k); B.UG = (bf16_t*)(ar + AR_UG - b1k); B.V = (bf16_t*)(ar + AR_V - b1k); B.MRG = (bf16_t*)(ar + AR_MRG - b1k);
        B.ACT = (bf16_t*)(ar + AR_ACT - bff); B.RAWB = (bf16_t*)(ar + AR_RAWB - gx * (GROUP_ROWS / 64) * 4 * NUP * 2); }
    if (threadIdx.x == 0) __hip_atomic_store((unsigned*)(P.ws + WS_CTL) + 1024 + blockIdx.x, ((unsigned)__builtin_amdgcn_s_getreg((3 << 11) | 20) & 0xFu) + 1u, __ATOMIC_RELAXED, __HIP_MEMORY_SCOPE_AGENT);
    if (blockIdx.x < 8 && threadIdx.x == 0) __hip_atomic_store((unsigned*)(P.ws + WS_CTL) + 64 * blockIdx.x, 0u, __ATOMIC_RELAXED, __HIP_MEMORY_SCOPE_AGENT);
    for (int d = 0; d < DUP_P0; ++d) { p0_phase(P, lds); grid.sync(); }
    unsigned* gctr = (unsigned*)(P.ws + WS_CTL) + 64 * (blockIdx.x & 7); unsigned gtarget = 0;
    int colocated = 0;
    if (gridDim.x == 256) {
        const unsigned* ids = (const unsigned*)(P.ws + WS_CTL) + 1024; const unsigned mine = __hip_atomic_load(ids + blockIdx.x, __ATOMIC_RELAXED, __HIP_MEMORY_SCOPE_AGENT);
        int same = 1;
        for (int j = 0; j < 32; ++j) same &= (__hip_atomic_load(ids + 8 * j + (blockIdx.x & 7), __ATOMIC_RELAXED, __HIP_MEMORY_SCOPE_AGENT) == mine);
        colocated = USE_COLOC ? __builtin_amdgcn_readfirstlane(same) : 0;
    }
    if (gridDim.x != 256) return;
    if (STAG_TICKS > 0 && (blockIdx.x & 7)) { const unsigned long long t0 = __builtin_amdgcn_s_memrealtime(), dt = (unsigned long long)(blockIdx.x & 7) * STAG_TICKS;
        while (__builtin_amdgcn_s_memrealtime() - t0 < dt) __builtin_amdgcn_s_sleep(8); }
#define GSYNC() do { for (int e_ = 0; e_ < DUP_SYNC; ++e_) { gtarget += 32; group_sync(gctr, gtarget, colocated); } } while (0)
#pragma unroll 1
    for (int l = 0; l < DEPTH; ++l) {
        for (int d = 0; d < DUP_GIN; ++d) {
            pg8::Gemm g{X, (const bf16_t*)(P.ws + WS_WIN) + (size_t)l * NIN * DM, MTOK, NIN, DM, LDX}; pg8::StaticOrder S; S.init(MTOK, NIN, G, (int)blockIdx.x);
            const int pm0 = pg8::fill_rs(lds, S, xss);
            pg8::EpiIn E{(const LAS float*)(lds + pg8::RS_OFF), pm0, B.CX, B.V, (float*)(P.ws + WS_VST), (size_t)(AR_BSG - AR_CX) / 2, d ? PROBE_SKIPEPI : 0};
            pg8::gemm_phase<pg8::EpiIn, pg8::StaticOrder>(lds, g, S, E, nullptr);
        }
        GSYNC();
        for (int d = 0; d < DUP_SGU; ++d) sgu_phase(P, B, lds, l);
        GSYNC();
        for (int d = 0; d < DUP_GOUT; ++d) {
            pg8::Gemm g{B.MRG, (const bf16_t*)(P.ws + WS_WOUT) + (size_t)l * DM * DM, MTOK, DM, DM, DM}; pg8::StaticOrder S; S.init(MTOK, DM, G, (int)blockIdx.x);
            pg8::EpiRes E{d ? (bf16_t*)(P.ws + 896 * MiB) : X, d ? (float*)(P.ws + 226 * MiB) : xss, d ? PROBE_NOLOAD : 0};
            pg8::gemm_phase<pg8::EpiRes, pg8::StaticOrder>(lds, g, S, E, nullptr);
        }
        GSYNC();
        for (int d = 0; d < DUP_GUP; ++d) {
            pg8::Gemm g{X, (const bf16_t*)(P.ws + WS_WUP) + (size_t)l * NUP * DM, MTOK, NUP, DM, LDX}; pg8::StaticOrder S; S.init(MTOK, NUP, G, (int)blockIdx.x);
            const int pm0 = pg8::fill_rs(lds, S, xss);
            pg8::EpiUp E{(const LAS float*)(lds + pg8::RS_OFF), pm0, P.conv_f + (size_t)l * 3 * NUP, (LAS unsigned char*)(lds + pg8::CWL_OFF), B.ACT, B.RAWB};
            pg8::gemm_phase<pg8::EpiUp, pg8::StaticOrder>(lds, g, S, E, nullptr);
        }
        GSYNC();
        for (int d = 0; d < DUP_FIX; ++d) fix_phase(P, B, l);
        GSYNC();
        for (int d = 0; d < DUP_GDN; ++d) {
            pg8::Gemm g{B.ACT, (const bf16_t*)(P.ws + WS_WDN) + (size_t)l * DM * DFF, MTOK, DM, DFF, LDA_ACT}; pg8::StaticOrder S; S.init(MTOK, DM, G, (int)blockIdx.x);
            pg8::EpiRes E{d ? (bf16_t*)(P.ws + 896 * MiB) : X, d ? (float*)(P.ws + 226 * MiB) : xss, d ? PROBE_NOLOAD : 0};
            pg8::gemm_phase<pg8::EpiRes, pg8::StaticOrder>(lds, g, S, E, nullptr);
        }
        GSYNC();
    }
    for (int d = 0; d < DUP_FIN; ++d) final_phase(P);
}

extern "C" void kernel_launch(void* const* d_in, const int* in_sizes, int n_in, void* d_out, int out_size, void* d_ws, size_t ws_size, hipStream_t stream) {
    static int grid_blocks = 0;
    if (!grid_blocks) {
        int dev = 0, cus = 0, per_cu = 0;
        hipGetDevice(&dev);
        hipDeviceGetAttribute(&cus, hipDeviceAttributeMultiprocessorCount, dev);
        hipFuncSetAttribute((const void*)fwd_megakernel, hipFuncAttributeMaxDynamicSharedMemorySize, LDS_BYTES);
        hipOccupancyMaxActiveBlocksPerMultiprocessor(&per_cu, (const void*)fwd_megakernel, 512, LDS_BYTES);
        if (per_cu < 1) { fprintf(stderr, "occupancy query says %d blocks/CU\n", per_cu); per_cu = 1; }
        grid_blocks = cus * 1;
        if (ws_size < WS_END) fprintf(stderr, "workspace too small: %zu < %zu\n", ws_size, (size_t)WS_END);
    }
    Params p{};
    p.x = (const float*)d_in[0]; p.mix_g = (const float*)d_in[1]; p.w_in = (const float*)d_in[2]; p.conv_a = (const float*)d_in[3]; p.ln_g = (const float*)d_in[4]; p.ln_b = (const float*)d_in[5];
    p.w_s = (const float*)d_in[6]; p.b_s = (const float*)d_in[7]; p.w_out = (const float*)d_in[8]; p.ffn_g = (const float*)d_in[9]; p.w_up = (const float*)d_in[10]; p.conv_f = (const float*)d_in[11];
    p.w_dn = (const float*)d_in[12]; p.fin_g = (const float*)d_in[13]; p.out = (float*)d_out; p.ws = (unsigned char*)d_ws;
    void* args[] = {&p};
    hipError_t e = hipLaunchCooperativeKernel((const void*)fwd_megakernel, dim3(grid_blocks), dim3(512), args, LDS_BYTES, stream);
    if (e != hipSuccess) fprintf(stderr, "cooperative launch failed: %s (grid %d)\n", hipGetErrorString(e), grid_blocks);
}
```
